# Optimizing an MI355X kernel written in HIP

```python
import jax, jax.numpy as jnp
from jax import lax
import numpy as np

D_MODEL = 1024
BATCH = 8
SEQ = 2048
DEPTH = 2

CHUNK = 64
D_INNER = 2 * D_MODEL

SB_WIDTH = D_INNER // 4
SB_HEAD_DIM = 64
SB_HEADS = SB_WIDTH // SB_HEAD_DIM
SB_BLOCK = 128

SSD_WIDTH = D_INNER // 2
SSD_HEAD_DIM = 64
SSD_HEADS = SSD_WIDTH // SSD_HEAD_DIM
SSD_GROUPS = 2
SSD_STATE = 128
SSD_CONV = 4
SSD_CONV_DIM = SSD_WIDTH + 2 * SSD_GROUPS * SSD_STATE

GLA_WIDTH = D_INNER // 4
GLA_HEADS = 4
GLA_KEY = GLA_WIDTH // 2
GLA_HEAD_K = GLA_KEY // GLA_HEADS
GLA_HEAD_V = GLA_WIDTH // GLA_HEADS
GLA_GATE_RANK = 16
GLA_GATE_TAU = 16.0

NORM_EPS = 1e-6

IN_SPLITS = (SB_WIDTH, SB_WIDTH, SB_WIDTH, SB_WIDTH,
             SSD_WIDTH, SSD_CONV_DIM, SSD_HEADS,
             GLA_KEY, GLA_KEY, GLA_WIDTH, GLA_WIDTH, GLA_GATE_RANK)
D_IN_PROJ = 4 * SB_WIDTH + SSD_WIDTH + SSD_CONV_DIM + SSD_HEADS + 2 * GLA_KEY + 2 * GLA_WIDTH + GLA_GATE_RANK

kernel_name = "hymba_style_sb_ssd_gla_trunk"


def _rms_norm(u, w):
    uf = u.astype(jnp.float32)
    y = uf * lax.rsqrt(jnp.mean(uf * uf, axis=-1, keepdims=True) + NORM_EPS)
    return y * w.astype(jnp.float32)


def _split_cols(u, sizes):
    outs = []
    start = 0
    for n in sizes:
        outs.append(u[..., start:start + n])
        start += n
    return outs


def _stick_breaking(q, k, v):
    b, s, h, d = q.shape
    scale = d ** -0.5
    outs = []
    for i in range(s // SB_BLOCK):
        q0 = i * SB_BLOCK
        kend = q0 + SB_BLOCK
        z = jnp.einsum("bthd,bshd->bhts", q[:, q0:kend], k[:, :kend]) * scale
        t_idx = q0 + jnp.arange(SB_BLOCK)
        s_idx = jnp.arange(kend)
        causal = s_idx[None, :] < t_idx[:, None]
        log_beta = jax.nn.log_sigmoid(z)
        log_rest = jnp.where(causal, jax.nn.log_sigmoid(-z), 0.0)
        after = lax.cumsum(log_rest, axis=3, reverse=True) - log_rest
        a = jnp.where(causal, jnp.exp(log_beta + after), 0.0)
        outs.append(jnp.einsum("bhts,bshd->bthd", a, v[:, :kend]))
    return jnp.concatenate(outs, axis=1)


def _causal_depthwise_conv(u, w, bias):
    c = u.shape[-1]
    out = lax.conv_general_dilated(
        u, w[:, None, :], window_strides=(1,), padding=[(w.shape[0] - 1, 0)],
        dimension_numbers=("NWC", "WIO", "NWC"), feature_group_count=c)
    return out + bias


def _ssd(xbc_raw, dt_raw, z, conv_w, conv_b, dt_bias, a_log, d_skip, norm_w):
    b, s, _ = xbc_raw.shape
    G, R, P, N = SSD_GROUPS, SSD_HEADS // SSD_GROUPS, SSD_HEAD_DIM, SSD_STATE
    c, l = s // CHUNK, CHUNK
    xbc = jax.nn.silu(_causal_depthwise_conv(xbc_raw, conv_w.astype(jnp.float32), conv_b.astype(jnp.float32)))
    xs, bm, cm = _split_cols(xbc, (SSD_WIDTH, G * N, G * N))
    x = xs.reshape(b, c, l, G, R, P)
    bm = bm.reshape(b, c, l, G, N)
    cm = cm.reshape(b, c, l, G, N)
    dt = jax.nn.softplus(dt_raw + dt_bias.astype(jnp.float32)).reshape(b, c, l, G, R)
    a = dt * (-jnp.exp(a_log.astype(jnp.float32))).reshape(G, R)
    a_cs = jnp.cumsum(a, axis=2)
    seg = a_cs[:, :, :, None] - a_cs[:, :, None, :]
    mask = (jnp.arange(l)[:, None] >= jnp.arange(l)[None, :])[None, None, :, :, None, None]
    decay = jnp.exp(jnp.where(mask, seg, -jnp.inf))
    scores = jnp.einsum("bclgn,bcmgn->bclmg", cm, bm)
    wts = scores[..., None] * decay * dt[:, :, None]
    y_diag = jnp.einsum("bclmgr,bcmgrp->bclgrp", wts, x)
    decay_end = jnp.exp(a_cs[:, :, -1:] - a_cs) * dt
    states = jnp.einsum("bclgn,bclgr,bclgrp->bcgrpn", bm, decay_end, x)
    chunk_decay = jnp.exp(a_cs[:, :, -1])

    def step(h, inp):
        st, dc = inp
        return dc[..., None, None] * h + st, h

    h0 = jnp.zeros((b, G, R, P, N), jnp.float32)
    _, prev = lax.scan(step, h0, (jnp.moveaxis(states, 1, 0), jnp.moveaxis(chunk_decay, 1, 0)))
    prev = jnp.moveaxis(prev, 0, 1)
    y_off = jnp.einsum("bclgn,bcgrpn,bclgr->bclgrp", cm, prev, jnp.exp(a_cs))
    y = y_diag + y_off + d_skip.astype(jnp.float32).reshape(G, R)[:, :, None] * x
    y = y.reshape(b, s, SSD_WIDTH) * jax.nn.silu(z)
    y = _rms_norm(y.reshape(b, s, G, SSD_WIDTH // G), jnp.ones((), jnp.float32)).reshape(b, s, SSD_WIDTH)
    return y * norm_w.astype(jnp.float32)


def _gla(q, k, v, g_lr, gate_w, gate_b, norm_w):
    b, s, _ = q.shape
    H, K, V = GLA_HEADS, GLA_HEAD_K, GLA_HEAD_V
    c, l = s // CHUNK, CHUNK
    log_g = jax.nn.log_sigmoid(g_lr @ gate_w.astype(jnp.float32) + gate_b.astype(jnp.float32)) / GLA_GATE_TAU

    def chunks(u, d):
        return jnp.moveaxis(u.reshape(b, c, l, H, d), 1, 0)

    qc = chunks(q * K ** -0.5, K)
    kc = chunks(k, K)
    vc = chunks(v, V)
    gc = chunks(log_g, K)
    causal = (jnp.arange(l)[:, None] >= jnp.arange(l)[None, :])[None, :, :, None, None]

    def step(S, inp):
        qi, ki, vi, gi = inp
        G = jnp.cumsum(gi, axis=1)
        o_inter = jnp.einsum("blhk,bhkv->blhv", qi * jnp.exp(G), S)
        dec = jnp.exp(jnp.where(causal, G[:, :, None] - G[:, None, :], -jnp.inf))
        att = jnp.einsum("bthk,bshk,btshk->bhts", qi, ki, dec)
        o_intra = jnp.einsum("bhts,bshv->bthv", att, vi)
        g_last = G[:, -1]
        S_new = jnp.exp(g_last)[..., None] * S + jnp.einsum(
            "bshk,bshv->bhkv", ki * jnp.exp(g_last[:, None] - G), vi)
        return S_new, o_inter + o_intra

    S0 = jnp.zeros((b, H, K, V), jnp.float32)
    _, o = lax.scan(step, S0, (qc, kc, vc, gc))
    o = jnp.moveaxis(o, 0, 1).reshape(b, s, H, V)
    o = _rms_norm(o, norm_w)
    return o.reshape(b, s, GLA_WIDTH)


def setup_inputs(seed: int = 0) -> dict:
    key = jax.random.key(seed)
    ks = jax.random.split(key, 16)
    f32 = jnp.float32
    x = jax.random.normal(ks[0], (BATCH, SEQ, D_MODEL), f32)
    norm_w = 1.0 + 0.02 * jax.random.normal(ks[1], (DEPTH, D_MODEL), f32)
    w_in = jax.random.normal(ks[2], (DEPTH, D_MODEL, D_IN_PROJ), f32) * D_MODEL ** -0.5
    ssd_conv_w = jax.random.normal(ks[3], (DEPTH, SSD_CONV, SSD_CONV_DIM), f32) * SSD_CONV ** -0.5
    ssd_conv_b = 0.02 * jax.random.normal(ks[4], (DEPTH, SSD_CONV_DIM), f32)
    dt0 = jnp.exp(jax.random.uniform(ks[5], (DEPTH, SSD_HEADS), f32) * (math_log(0.1) - math_log(0.001)) + math_log(0.001))
    ssd_dt_bias = dt0 + jnp.log(-jnp.expm1(-dt0))
    ssd_a_log = jnp.log(jax.random.uniform(ks[6], (DEPTH, SSD_HEADS), f32, 1.0, 16.0))
    ssd_d = 1.0 + 0.02 * jax.random.normal(ks[7], (DEPTH, SSD_HEADS), f32)
    ssd_norm_w = 1.0 + 0.02 * jax.random.normal(ks[8], (DEPTH, SSD_WIDTH), f32)
    gla_gate_w = jax.random.normal(ks[9], (DEPTH, GLA_GATE_RANK, GLA_KEY), f32) * GLA_GATE_RANK ** -0.5
    gla_gate_b = 0.1 * jax.random.normal(ks[10], (DEPTH, GLA_KEY), f32)
    gla_norm_w = 1.0 + 0.02 * jax.random.normal(ks[11], (DEPTH, GLA_HEAD_V), f32)
    w_out = jax.random.normal(ks[12], (DEPTH, D_INNER, D_MODEL), f32) * D_INNER ** -0.5
    final_norm_w = 1.0 + 0.02 * jax.random.normal(ks[13], (D_MODEL,), f32)
    return {"x": x, "norm_w": norm_w, "w_in": w_in, "ssd_conv_w": ssd_conv_w,
            "ssd_conv_b": ssd_conv_b, "ssd_dt_bias": ssd_dt_bias, "ssd_a_log": ssd_a_log,
            "ssd_d": ssd_d, "ssd_norm_w": ssd_norm_w, "gla_gate_w": gla_gate_w,
            "gla_gate_b": gla_gate_b, "gla_norm_w": gla_norm_w, "w_out": w_out,
            "final_norm_w": final_norm_w}


def math_log(v):
    return float(np.log(v))


def reference(x, norm_w, w_in, ssd_conv_w, ssd_conv_b, ssd_dt_bias, ssd_a_log, ssd_d,
              ssd_norm_w, gla_gate_w, gla_gate_b, gla_norm_w, w_out, final_norm_w):
    b, s, _ = x.shape
    for layer in range(DEPTH):
        h = _rms_norm(x, norm_w[layer])
        proj = h @ w_in[layer].astype(jnp.float32)
        (sb_q, sb_k, sb_v, sb_z, ssd_z, ssd_xbc, ssd_dt,
         gla_q, gla_k, gla_v, gla_z, gla_glr) = _split_cols(proj, IN_SPLITS)
        y_a = _stick_breaking(sb_q.reshape(b, s, SB_HEADS, SB_HEAD_DIM),
                              sb_k.reshape(b, s, SB_HEADS, SB_HEAD_DIM),
                              sb_v.reshape(b, s, SB_HEADS, SB_HEAD_DIM)).reshape(b, s, SB_WIDTH)
        y_a = y_a * jax.nn.silu(sb_z)
        y_b = _ssd(ssd_xbc, ssd_dt, ssd_z, ssd_conv_w[layer], ssd_conv_b[layer],
                   ssd_dt_bias[layer], ssd_a_log[layer], ssd_d[layer], ssd_norm_w[layer])
        y_c = _gla(gla_q, gla_k, gla_v, gla_glr, gla_gate_w[layer], gla_gate_b[layer],
                   gla_norm_w[layer]) * jax.nn.silu(gla_z)
        y = jnp.concatenate([y_a, y_b, y_c], axis=-1) @ w_out[layer].astype(jnp.float32)
        x = (x.astype(jnp.float32) + y).astype(x.dtype)
    return _rms_norm(x, final_norm_w).astype(x.dtype)
```

```cpp
#include <hip/hip_runtime.h>
#include <cstdio>
#include <cstdint>

constexpr int D_MODEL = 1024, BATCH = 8, SEQ = 2048, DEPTH = 2;
constexpr int NPROJ = 6176, D_INNER = 2048;
constexpr int C_SBQ = 0, C_SBK = 512, C_SBV = 1024, C_SBZ = 1536, C_SSDZ = 2048, C_XBC = 3072, C_DT = 4608,
              C_GQ = 4624, C_GK = 4880, C_GV = 5136, C_GZ = 5648, C_GLR = 6160;
constexpr float EPS = 1e-6f;

__device__ __forceinline__ float siluf(float x) { return x / (1.f + expf(-x)); }
__device__ __forceinline__ float softplusf(float x) { return fmaxf(x, 0.f) + log1pf(expf(-fabsf(x))); }
__device__ __forceinline__ float logsigf(float x) { return fminf(x, 0.f) - log1pf(expf(-fabsf(x))); }

__device__ __forceinline__ float block_sum(float v, float* red) {
    for (int o = 32; o > 0; o >>= 1) v += __shfl_xor(v, o);
    const int w = threadIdx.x >> 6, l = threadIdx.x & 63, nw = blockDim.x >> 6;
    __syncthreads();
    if (l == 0) red[w] = v;
    __syncthreads();
    float s = 0.f;
    for (int i = 0; i < nw; ++i) s += red[i];
    return s;
}

__global__ void k_rmsnorm(const float* x, const float* __restrict__ w, float* out) {
    __shared__ float red[8];
    const size_t r = blockIdx.x;
    const float* xr = x + r * D_MODEL;
    float v[4]; float s = 0.f;
    for (int j = 0; j < 4; ++j) { v[j] = xr[threadIdx.x + 256 * j]; s += v[j] * v[j]; }
    s = block_sum(s, red);
    const float rs = rsqrtf(s / D_MODEL + EPS);
    for (int j = 0; j < 4; ++j) out[r * D_MODEL + threadIdx.x + 256 * j] = v[j] * rs * w[threadIdx.x + 256 * j];
}

__global__ void k_gemm(const float* __restrict__ A, const float* __restrict__ B, float* __restrict__ C, int M, int N, int K, int lda, int ldb, int ldc) {
    __shared__ float As[16][64 + 1];
    __shared__ float Bs[16][64 + 1];
    const int tx = threadIdx.x & 15, ty = threadIdx.x >> 4;
    const int m0 = blockIdx.y * 64, n0 = blockIdx.x * 64;
    float acc[4][4] = {};
    for (int k0 = 0; k0 < K; k0 += 16) {
        for (int i = threadIdx.x; i < 64 * 16; i += 256) {
            const int r = i >> 4, c = i & 15;
            As[c][r] = A[(size_t)(m0 + r) * lda + k0 + c];
        }
        for (int i = threadIdx.x; i < 16 * 64; i += 256) {
            const int r = i >> 6, c = i & 63;
            Bs[r][c] = (n0 + c < N) ? B[(size_t)(k0 + r) * ldb + n0 + c] : 0.f;
        }
        __syncthreads();
        for (int k = 0; k < 16; ++k) {
            float a[4], b[4];
            for (int i = 0; i < 4; ++i) a[i] = As[k][ty * 4 + i];
            for (int j = 0; j < 4; ++j) b[j] = Bs[k][tx * 4 + j];
            for (int i = 0; i < 4; ++i) for (int j = 0; j < 4; ++j) acc[i][j] += a[i] * b[j];
        }
        __syncthreads();
    }
    for (int i = 0; i < 4; ++i) for (int j = 0; j < 4; ++j) {
        const int n = n0 + tx * 4 + j;
        if (n < N) C[(size_t)(m0 + ty * 4 + i) * ldc + n] = acc[i][j];
    }
}

__global__ void __launch_bounds__(64) k_sb(const float* __restrict__ proj, float* __restrict__ Y) {
    const int idx = blockIdx.x * blockDim.x + threadIdx.x;
    const int t = idx % SEQ, h = idx / SEQ;
    if (h >= 8) return;
    float q[64], o[64];
    const float* qp = proj + (size_t)t * NPROJ + C_SBQ + h * 64;
#pragma unroll
    for (int d = 0; d < 64; ++d) { q[d] = qp[d]; o[d] = 0.f; }
    float R = 1.f;
    for (int s = t - 1; s >= 0; --s) {
        const float* kp = proj + (size_t)s * NPROJ + C_SBK + h * 64;
        const float* vp = proj + (size_t)s * NPROJ + C_SBV + h * 64;
        float z = 0.f;
#pragma unroll
        for (int d = 0; d < 64; ++d) z += q[d] * kp[d];
        z *= 0.125f;
        const float e = expf(-fabsf(z));
        const float big = 1.f / (1.f + e), small = e / (1.f + e);
        const float beta = z >= 0.f ? big : small, omb = z >= 0.f ? small : big;
        const float a = beta * R;
#pragma unroll
        for (int d = 0; d < 64; ++d) o[d] += a * vp[d];
        R *= omb;
        if (R == 0.f) break;
    }
    const float* zp = proj + (size_t)t * NPROJ + C_SBZ + h * 64;
#pragma unroll
    for (int d = 0; d < 64; ++d) Y[(size_t)t * D_INNER + h * 64 + d] = o[d] * siluf(zp[d]);
}

__global__ void k_conv(const float* __restrict__ proj, const float* __restrict__ cw, const float* __restrict__ cb, float* __restrict__ xc) {
    const int idx = blockIdx.x * blockDim.x + threadIdx.x;
    if (idx >= SEQ * 1536) return;
    const int t = idx / 1536, c = idx % 1536;
    float acc = cb[c];
    for (int k = 0; k < 4; ++k) { const int tt = t - 3 + k; if (tt >= 0) acc += cw[k * 1536 + c] * proj[(size_t)tt * NPROJ + C_XBC + c]; }
    xc[idx] = siluf(acc);
}

__global__ void __launch_bounds__(64) k_ssd(const float* __restrict__ proj, const float* __restrict__ xc, const float* __restrict__ dt_bias, const float* __restrict__ a_log,
                      const float* __restrict__ dskip, float* __restrict__ yssd) {
    __shared__ float Bs[16][128], Cs[16][128], dts[16];
    const int hh = blockIdx.x, p = threadIdx.x, g = hh / 8;
    float h[128];
#pragma unroll
    for (int n = 0; n < 128; ++n) h[n] = 0.f;
    const float A = -expf(a_log[hh]), Dk = dskip[hh], dtb = dt_bias[hh];
    for (int t0 = 0; t0 < SEQ; t0 += 16) {
        __syncthreads();
        for (int i = threadIdx.x; i < 16 * 128; i += 64) {
            const int r = i >> 7, n = i & 127;
            Bs[r][n] = xc[(size_t)(t0 + r) * 1536 + 1024 + g * 128 + n];
            Cs[r][n] = xc[(size_t)(t0 + r) * 1536 + 1280 + g * 128 + n];
        }
        if (threadIdx.x < 16) dts[threadIdx.x] = softplusf(proj[(size_t)(t0 + threadIdx.x) * NPROJ + C_DT + hh] + dtb);
        __syncthreads();
        for (int r = 0; r < 16; ++r) {
            const int t = t0 + r;
            const float dt = dts[r], dA = expf(dt * A);
            const float xv = xc[(size_t)t * 1536 + hh * 64 + p];
            const float dx = dt * xv;
            float y = 0.f;
#pragma unroll
            for (int n = 0; n < 128; ++n) { h[n] = dA * h[n] + dx * Bs[r][n]; y += Cs[r][n] * h[n]; }
            yssd[(size_t)t * 1024 + hh * 64 + p] = y + Dk * xv;
        }
    }
}

__global__ void k_ssd_norm(const float* __restrict__ yssd, const float* __restrict__ proj, const float* __restrict__ nw, float* __restrict__ Y) {
    __shared__ float red[8];
    const int t = blockIdx.x >> 1, g = blockIdx.x & 1;
    float v[2]; float s = 0.f;
    for (int j = 0; j < 2; ++j) { const int c = g * 512 + threadIdx.x + 256 * j; v[j] = yssd[(size_t)t * 1024 + c] * siluf(proj[(size_t)t * NPROJ + C_SSDZ + c]); s += v[j] * v[j]; }
    s = block_sum(s, red);
    const float rs = rsqrtf(s / 512.f + EPS);
    for (int j = 0; j < 2; ++j) { const int c = g * 512 + threadIdx.x + 256 * j; Y[(size_t)t * D_INNER + 512 + c] = v[j] * rs * nw[c]; }
}

__global__ void k_gla_gate(const float* __restrict__ proj, const float* __restrict__ gw, const float* __restrict__ gb, float* __restrict__ logg) {
    const int idx = blockIdx.x * blockDim.x + threadIdx.x;
    if (idx >= SEQ * 256) return;
    const int t = idx >> 8, j = idx & 255;
    float a = gb[j];
    for (int r = 0; r < 16; ++r) a += proj[(size_t)t * NPROJ + C_GLR + r] * gw[r * 256 + j];
    logg[idx] = logsigf(a) * (1.f / 16.f);
}

__global__ void __launch_bounds__(64) k_gla(const float* __restrict__ proj, const float* __restrict__ logg, float* __restrict__ go) {
    __shared__ float qs[16][64], ks[16][64], gs[16][64];
    const int h = blockIdx.x >> 1, v = (blockIdx.x & 1) * 64 + threadIdx.x;
    float S[64];
#pragma unroll
    for (int k = 0; k < 64; ++k) S[k] = 0.f;
    for (int t0 = 0; t0 < SEQ; t0 += 16) {
        __syncthreads();
        for (int i = threadIdx.x; i < 16 * 64; i += 64) {
            const int r = i >> 6, k = i & 63;
            qs[r][k] = proj[(size_t)(t0 + r) * NPROJ + C_GQ + h * 64 + k] * 0.125f;
            ks[r][k] = proj[(size_t)(t0 + r) * NPROJ + C_GK + h * 64 + k];
            gs[r][k] = expf(logg[(size_t)(t0 + r) * 256 + h * 64 + k]);
        }
        __syncthreads();
        for (int r = 0; r < 16; ++r) {
            const int t = t0 + r;
            const float vv = proj[(size_t)t * NPROJ + C_GV + h * 128 + v];
            float o = 0.f;
#pragma unroll
            for (int k = 0; k < 64; ++k) { S[k] = gs[r][k] * S[k] + ks[r][k] * vv; o += qs[r][k] * S[k]; }
            go[(size_t)t * 512 + h * 128 + v] = o;
        }
    }
}

__global__ void k_gla_norm(const float* __restrict__ go, const float* __restrict__ proj, const float* __restrict__ nw, float* __restrict__ Y) {
    const int t = blockIdx.x, c = threadIdx.x, v = c & 127;
    const float o = go[(size_t)t * 512 + c];
    float s = o * o;
    for (int off = 32; off > 0; off >>= 1) s += __shfl_xor(s, off);
    __shared__ float red[8];
    if ((threadIdx.x & 63) == 0) red[threadIdx.x >> 6] = s;
    __syncthreads();
    const int hw = (c >> 7) * 2;
    const float ms = (red[hw] + red[hw + 1]) / 128.f;
    const float on = o * rsqrtf(ms + EPS) * nw[v];
    Y[(size_t)t * D_INNER + 1536 + c] = on * siluf(proj[(size_t)t * NPROJ + C_GZ + c]);
}

__global__ void k_add(const float* __restrict__ a, const float* __restrict__ b, float* __restrict__ o, int n) {
    const int i = blockIdx.x * blockDim.x + threadIdx.x;
    if (i < n) o[i] = a[i] + b[i];
}

extern "C" void kernel_launch(void* const* d_in, const int* in_sizes, int n_in, void* d_out, int out_size, void* d_ws, size_t ws_size, hipStream_t stream) {
    const float* x = (const float*)d_in[0];
    const float* norm_w = (const float*)d_in[1];
    const float* w_in = (const float*)d_in[2];
    const float* conv_w = (const float*)d_in[3];
    const float* conv_b = (const float*)d_in[4];
    const float* dt_bias = (const float*)d_in[5];
    const float* a_log = (const float*)d_in[6];
    const float* ssd_d = (const float*)d_in[7];
    const float* ssd_nw = (const float*)d_in[8];
    const float* gate_w = (const float*)d_in[9];
    const float* gate_b = (const float*)d_in[10];
    const float* gla_nw = (const float*)d_in[11];
    const float* w_out = (const float*)d_in[12];
    const float* fin_w = (const float*)d_in[13];
    float* out = (float*)d_out;
    float* ws = (float*)d_ws;
    float* XN = ws;
    float* proj = XN + (size_t)SEQ * 1024;
    float* xc = proj + (size_t)SEQ * NPROJ;
    float* yssd = xc + (size_t)SEQ * 1536;
    float* logg = yssd + (size_t)SEQ * 1024;
    float* go = logg + (size_t)SEQ * 256;
    float* Y = go + (size_t)SEQ * 512;
    float* tmp = Y + (size_t)SEQ * 2048;
    for (int l = 0; l < DEPTH; ++l) {
        for (int b = 0; b < BATCH; ++b) {
            const float* xin = (l == 0 ? x : out) + (size_t)b * SEQ * 1024;
            float* xo = out + (size_t)b * SEQ * 1024;
            k_rmsnorm<<<SEQ, 256, 0, stream>>>(xin, norm_w + l * 1024, XN);
            k_gemm<<<dim3((NPROJ + 63) / 64, SEQ / 64), 256, 0, stream>>>(XN, w_in + (size_t)l * 1024 * NPROJ, proj, SEQ, NPROJ, 1024, 1024, NPROJ, NPROJ);
            k_sb<<<SEQ * 8 / 64, 64, 0, stream>>>(proj, Y);
            k_conv<<<SEQ * 1536 / 256, 256, 0, stream>>>(proj, conv_w + l * 4 * 1536, conv_b + l * 1536, xc);
            k_ssd<<<16, 64, 0, stream>>>(proj, xc, dt_bias + l * 16, a_log + l * 16, ssd_d + l * 16, yssd);
            k_ssd_norm<<<SEQ * 2, 256, 0, stream>>>(yssd, proj, ssd_nw + l * 1024, Y);
            k_gla_gate<<<SEQ * 256 / 256, 256, 0, stream>>>(proj, gate_w + l * 16 * 256, gate_b + l * 256, logg);
            k_gla<<<8, 64, 0, stream>>>(proj, logg, go);
            k_gla_norm<<<SEQ, 512, 0, stream>>>(go, proj, gla_nw + l * 128, Y);
            k_gemm<<<dim3(1024 / 64, SEQ / 64), 256, 0, stream>>>(Y, w_out + (size_t)l * 2048 * 1024, tmp, SEQ, 1024, 2048, 2048, 1024, 1024);
            k_add<<<SEQ * 1024 / 256, 256, 0, stream>>>(xin, tmp, xo, SEQ * 1024);
        }
    }
    k_rmsnorm<<<BATCH * SEQ, 256, 0, stream>>>(out, fin_w, out);
}
```

```cpp
#include <hip/hip_runtime.h>
#include <cstdio>
#include <cstdint>
namespace pg8 {
#define PG8_LAS __attribute__((address_space(3)))
typedef unsigned short bf16_t;
typedef short bf16x8 __attribute__((ext_vector_type(8)));
typedef float f32x4 __attribute__((ext_vector_type(4)));
typedef unsigned u32x4 __attribute__((ext_vector_type(4)));
typedef unsigned u32x2 __attribute__((ext_vector_type(2)));
constexpr int BM = 256, BK = 64, HALF = 128, HTB = HALF * BK * 2  , STAGE_BYTES = 8 * HTB, NXCD = 8, WGM = 8;

__host__ __device__ __forceinline__ int lds_byte(int r, int c) { const int st = (r >> 4) * 2 + (c >> 5), rr = r & 15, cc = c & 31, ob = rr * 64 + cc * 2; return st * 1024 + (ob ^ (((ob >> 9) & 1) << 5)); }
__host__ __device__ __forceinline__ void stage_rc(int b, int& R, int& C) { const int st = b / 1024, sb = b % 1024, swz = sb ^ (((sb >> 9) & 1) << 5); R = (st >> 1) * 16 + swz / 64; C = (st & 1) * 32 + (swz % 64) / 2; }
__host__ __device__ __forceinline__ int perm32(int rho) { const int n = rho >> 4, i = rho & 15; return 8 * (i >> 2) + 4 * n + (i & 3); }

struct Unit { int pm, pn; };
struct Gemm { const bf16_t* A; const bf16_t* Bt; int M, N, K, lda; };

struct StaticOrder {
    int nM, nN, nwg, G, c;
    __host__ __device__ void init(int M, int N, int G_, int c_) { nM = M / BM; nN = N / BM; nwg = nM * nN; G = G_; c = c_; }
    __host__ __device__ bool next(int i, Unit& u) const {
        const long L = (long)i * G + c; if (L >= nwg) return false;
        int wgid = (int)L; { const int q = nwg / NXCD, r = nwg % NXCD, xcd = wgid % NXCD, off = wgid / NXCD; wgid = (xcd < r ? xcd * (q + 1) : r * (q + 1) + (xcd - r) * q) + off; }
        const int nig = WGM * nN, gid = wgid / nig, fm = gid * WGM, gsz = (nM - fm) < WGM ? (nM - fm) : WGM;
        u.pm = fm + ((wgid % nig) % gsz); u.pn = (wgid % nig) / gsz; return true;
    }
};

__device__ __forceinline__ unsigned cvt_pk_bf16(float lo, float hi) { unsigned r; asm volatile("v_cvt_pk_bf16_f32 %0, %1, %2" : "=v"(r) : "v"(lo), "v"(hi)); return r; }

template <class Epi, bool ALIGN_EPI, bool HORNER, int K, int lda>
__device__ __forceinline__ void gemm_phase(PG8_LAS unsigned char* lds, const Gemm g, const StaticOrder& S, const Epi& E, const PG8_LAS float* hsc) {
    int tid_ = threadIdx.x; asm volatile("" : "+v"(tid_));
    const int tid = tid_, wid = __builtin_amdgcn_readfirstlane(tid >> 6), lane = tid & 63, wr = wid >> 2, wc = wid & 3, fr = lane & 15, fq = lane >> 4;
    constexpr int nt = K / BK;
    unsigned voffA[2], voffB[2];
#pragma unroll
    for (int i = 0; i < 2; ++i) { int R, C; stage_rc(tid * 16 + i * 8192, R, C); const int Rb = Epi::PERM ? ((R & ~31) + perm32(R & 31)) : R;
        voffA[i] = (unsigned)(R * lda + C) * 2u; voffB[i] = (unsigned)(Rb * K + C) * 2u; }
    constexpr size_t kstep = (size_t)(BK * 2);
    constexpr size_t hstepA = (size_t)HALF * lda * 2, hstepB = (size_t)HALF * K * 2;
    constexpr size_t tstepA = 2 * hstepA, tstepB = 2 * hstepB;
    const unsigned ldsw = (unsigned)wid * 1024u;
    const int aoff = lds_byte(wr * 64 + fr, fq * 8), boff = lds_byte(wc * 32 + fr, fq * 8);
#define PG8_SA(b, h) (((b) * 2 + (h)) * HTB)
#define PG8_SB(b, h) ((4 + (b) * 2 + (h)) * HTB)
#define PG8_STAGE(bufoff, gbase, voff) do { _Pragma("unroll") for (int _i = 0; _i < 2; ++_i) \
        __builtin_amdgcn_global_load_lds((const unsigned*)((const char*)(gbase) + (voff)[_i]), (PG8_LAS unsigned*)(lds + (bufoff) + ldsw + _i * 8192), 16, 0, 0); } while (0)
#define PG8_LDA(dst, b, h) do { _Pragma("unroll") for (int m = 0; m < 4; ++m) _Pragma("unroll") for (int k = 0; k < 2; ++k) dst[m][k] = *(const PG8_LAS bf16x8*)(lds + PG8_SA(b, h) + aoff + m * 2048 + k * 1024); } while (0)
#define PG8_LDB(dst, b, h) do { _Pragma("unroll") for (int n = 0; n < 2; ++n) _Pragma("unroll") for (int k = 0; k < 2; ++k) dst[n][k] = *(const PG8_LAS bf16x8*)(lds + PG8_SB(b, h) + boff + n * 2048 + k * 1024); } while (0)
#define PG8_MMA(ai, bj, At, Bt) do { __builtin_amdgcn_s_setprio(1); _Pragma("unroll") for (int m = 0; m < 4; ++m) _Pragma("unroll") for (int n = 0; n < 2; ++n) _Pragma("unroll") for (int k = 0; k < 2; ++k) \
        acc[ai][bj][m][n] = __builtin_amdgcn_mfma_f32_16x16x32_bf16(Bt[n][k], At[m][k], acc[ai][bj][m][n], 0, 0, 0); __builtin_amdgcn_s_setprio(0); } while (0)
#define PG8_WAIT_V(n) asm volatile("s_waitcnt vmcnt(" #n ")" ::: "memory")
#define PG8_WAIT_L(n) asm volatile("s_waitcnt lgkmcnt(" #n ")" ::: "memory")
#define PG8_BAR __builtin_amdgcn_s_barrier()
#define PG8_SCHED __builtin_amdgcn_sched_barrier(0)
    Unit cur, nxt; int ui = 0;
    if (!S.next(0, cur)) return;
    f32x4 acc[2][2][4][2];
#pragma unroll
    for (int a = 0; a < 2; ++a)
#pragma unroll
        for (int b = 0; b < 2; ++b)
#pragma unroll
            for (int m = 0; m < 4; ++m)
#pragma unroll
                for (int n = 0; n < 2; ++n) acc[a][b][m][n] = (f32x4){0.f, 0.f, 0.f, 0.f};
    bf16x8 At[4][2], B0[2][2], B1[2][2];
    const char* cA = (const char*)g.A + (size_t)cur.pm * tstepA; const char* cB = (const char*)g.Bt + (size_t)cur.pn * tstepB;
    PG8_STAGE(PG8_SB(0, 0), cB, voffB); PG8_STAGE(PG8_SB(0, 1), cB + hstepB, voffB); PG8_STAGE(PG8_SA(0, 0), cA, voffA); PG8_STAGE(PG8_SA(0, 1), cA + hstepA, voffA);
    if (wr == 1) PG8_BAR;
    PG8_WAIT_V(2); PG8_BAR;
    PG8_STAGE(PG8_SB(1, 0), cB + kstep, voffB); PG8_STAGE(PG8_SA(1, 0), cA + kstep, voffA); PG8_STAGE(PG8_SB(1, 1), cB + hstepB + kstep, voffB);
    PG8_WAIT_V(6); PG8_BAR;
    for (;;) {
        const bool has_next = S.next(ui + 1, nxt);
        const char* nA = has_next ? (const char*)g.A + (size_t)nxt.pm * tstepA : cA; const char* nB = has_next ? (const char*)g.Bt + (size_t)nxt.pn * tstepB : cB;
        for (int t = 0; t < nt; t += 2) {
            const bool last = (t == nt - 2);
            const char* a1 = cA + (size_t)(t + 1) * kstep;
            const char* a2 = last ? nA : cA + (size_t)(t + 2) * kstep; const char* b2 = last ? nB : cB + (size_t)(t + 2) * kstep;
            const char* a3 = a2 + kstep; const char* b3 = b2 + kstep;
            if constexpr (HORNER) {
                if (t == 8 || t == 16) { const int hc = (t == 8) ? 0 : 1;
#pragma unroll
                    for (int ai = 0; ai < 2; ++ai)
#pragma unroll
                        for (int m = 0; m < 4; ++m) { const float f = hsc[(ai * HALF + wr * 64 + m * 16 + fr) * 2 + hc];
#pragma unroll
                            for (int bj = 0; bj < 2; ++bj)
#pragma unroll
                                for (int n = 0; n < 2; ++n) acc[ai][bj][m][n] = acc[ai][bj][m][n] * f; }
                    PG8_WAIT_L(0); PG8_SCHED; }
            }
            PG8_LDB(B0, 0, 0); PG8_LDB(B1, 0, 1); PG8_SCHED; PG8_LDA(At, 0, 0); PG8_STAGE(PG8_SA(1, 1), a1 + hstepA, voffA);
            PG8_WAIT_V(8); PG8_WAIT_L(0); PG8_BAR; PG8_MMA(0, 0, At, B0); PG8_MMA(0, 1, At, B1); PG8_BAR; PG8_SCHED;
            PG8_LDA(At, 0, 1); PG8_STAGE(PG8_SB(0, 0), b2, voffB); PG8_STAGE(PG8_SB(0, 1), b2 + hstepB, voffB); PG8_STAGE(PG8_SA(0, 0), a2, voffA);
            PG8_WAIT_V(8); PG8_WAIT_L(0); PG8_BAR; PG8_MMA(1, 0, At, B0); PG8_MMA(1, 1, At, B1); PG8_BAR; PG8_SCHED;
            PG8_LDB(B0, 1, 0); PG8_LDB(B1, 1, 1); PG8_SCHED; PG8_LDA(At, 1, 0); PG8_STAGE(PG8_SA(0, 1), a2 + hstepA, voffA);
            PG8_WAIT_V(8); PG8_WAIT_L(0); PG8_BAR; PG8_MMA(0, 0, At, B0); PG8_MMA(0, 1, At, B1); PG8_BAR; PG8_SCHED;
            PG8_LDA(At, 1, 1); PG8_STAGE(PG8_SB(1, 0), b3, voffB); PG8_STAGE(PG8_SB(1, 1), b3 + hstepB, voffB); PG8_STAGE(PG8_SA(1, 0), a3, voffA);
            PG8_WAIT_V(8); PG8_WAIT_L(0); PG8_BAR; PG8_MMA(1, 0, At, B0); PG8_MMA(1, 1, At, B1); PG8_BAR; PG8_SCHED;
        }
        if constexpr (ALIGN_EPI) { if (wr == 0) PG8_BAR; }
        if constexpr (!Epi::AFTER_DRAIN) { E(acc, cur, wr, wc, fr, fq); }
        if (!has_next) break;
#pragma unroll
        for (int a = 0; a < 2; ++a)
#pragma unroll
            for (int b = 0; b < 2; ++b)
#pragma unroll
                for (int m = 0; m < 4; ++m)
#pragma unroll
                    for (int n = 0; n < 2; ++n) acc[a][b][m][n] = (f32x4){0.f, 0.f, 0.f, 0.f};
        cur = nxt; cA = nA; cB = nB; ++ui;
        if constexpr (ALIGN_EPI) { if (wr == 1) PG8_BAR; }
    }
    PG8_WAIT_V(0);
    if constexpr (!ALIGN_EPI) { if (wr == 0) PG8_BAR; }
    PG8_BAR;
    if constexpr (Epi::AFTER_DRAIN) { E.fused(acc, cur, wr, wc, fr, fq); }
#undef PG8_SA
#undef PG8_SB
#undef PG8_STAGE
#undef PG8_LDA
#undef PG8_LDB
#undef PG8_MMA
#undef PG8_WAIT_V
#undef PG8_WAIT_L
#undef PG8_BAR
#undef PG8_SCHED
}
}
constexpr int NWAVES = 8;
constexpr int BATCH = 8, SEQ = 2048, T = BATCH * SEQ, DM = 1024, DEPTH = 2;
constexpr int NPROJ = 6176, PP = 6400  , DI = 2048;
constexpr float EPS = 1e-6f;
constexpr int PC_Y = 0;
constexpr int PC_SSDZ = 0, PC_SBZ = 1024, PC_GZ = 1536;
constexpr int PC_SBQ = 2048, PC_SBK = 2560, PC_SBV = 3072;
constexpr int PC_XBC = 3584  , PC_DT = 5120, PC_GQ = 5136, PC_GK = 5392, PC_GV = 5648, PC_GLR = 6160;
__host__ __device__ __forceinline__ int proj_orig_col(int n) {
    if (n < 1024) return 2048 + n;
    if (n < 1536) return 1536 + (n - 1024);
    if (n < 2048) return 5648 + (n - 1536);
    if (n < 3584) return n - 2048;
    if (n < 5136) return 3072 + (n - 3584);
    if (n < 6160) return n - 512;
    return n;
}
__host__ __device__ __forceinline__ int wout_src_row(int kk) { return kk < 1024 ? 512 + kk : (kk < 1536 ? kk - 1024 : kk); }

constexpr size_t MiB = 1u << 20;
constexpr size_t WS_CTL = 0, CTL_ZERO_BYTES = 1 * MiB;
constexpr size_t WS_WIN = 1 * MiB;
constexpr size_t WS_WOUT = 14 * MiB;
constexpr size_t WS_XB = 18 * MiB;
constexpr size_t WS_PROJ = 50 * MiB;
constexpr size_t WS_END = 250 * MiB;
static_assert(WS_WIN + (size_t)PP * DM * 2 <= WS_WOUT && WS_WOUT + (size_t)DM * DI * 2 <= WS_XB && WS_XB + (size_t)T * DM * 2 <= WS_PROJ && WS_PROJ + (size_t)T * PP * 2 <= WS_END, "ws map");
constexpr int CW_TMO = 0, CW_CODE = 1;
constexpr int CW_BAR = 4096;
constexpr int CW_Q = 8192;
constexpr int CW_SSQX = 32768;
constexpr int CW_SSQG = CW_SSQX + 3 * T;
static_assert((CW_SSQG + 2 * T * 2) * 4 <= (int)CTL_ZERO_BYTES, "CTL");

constexpr int RING_OFF = 0, RING_BYTES = 131072;
constexpr int HSC_OFF = RING_BYTES;
constexpr int LDSCTL_OFF = HSC_OFF + 2048, MISC_OFF = LDSCTL_OFF + 320;
constexpr int LDS_BYTES = 147456;
static_assert(MISC_OFF + 128 <= LDS_BYTES, "LDS map");

#define GAS __attribute__((address_space(1)))
#define LAS __attribute__((address_space(3)))
typedef unsigned short bf16;
typedef unsigned v4u __attribute__((ext_vector_type(4)));
typedef unsigned v2u __attribute__((ext_vector_type(2)));
typedef float f32x4 __attribute__((ext_vector_type(4)));
typedef GAS unsigned gu32;
#define RLX_AGENT __ATOMIC_RELAXED, __HIP_MEMORY_SCOPE_AGENT
#define LDS_WAIT() asm volatile("s_waitcnt lgkmcnt(0)" ::: "memory")
#define VM_WAIT() asm volatile("s_waitcnt vmcnt(0)" ::: "memory")
__device__ __forceinline__ unsigned f2bf(float f) { unsigned u = __builtin_bit_cast(unsigned, f); return (u + 0x7fffu + ((u >> 16) & 1u)) >> 16; }
__device__ __forceinline__ unsigned pk2(float lo, float hi) { return f2bf(lo) | (f2bf(hi) << 16); }
__device__ __forceinline__ float bf2f(bf16 v) { return __builtin_bit_cast(float, (unsigned)v << 16); }
__device__ __forceinline__ float bflo(unsigned w) { return __builtin_bit_cast(float, w << 16); }
__device__ __forceinline__ float bfhi(unsigned w) { return __builtin_bit_cast(float, w & 0xffff0000u); }
__device__ __forceinline__ float siluf(float x) { return x / (1.f + __expf(-x)); }
__device__ __forceinline__ float softplusf(float x) { return fmaxf(x, 0.f) + log1pf(expf(-fabsf(x))); }
__device__ __forceinline__ float logsigf(float x) { return fminf(x, 0.f) - log1pf(expf(-fabsf(x))); }

#define XB_TMO      128
#define XB_XCNT(j)  (256  + 64 * (j))
#define XB_XSUB(j)  (1280 + 64 * (j))
#define XB_XGEN(j)  (2304 + 64 * (j))
#define XB_TOP      3328
#define XB_TOPGEN   3392
#define XCD_BAR_WORDS 3456
#define XB_SPIN_CAP (1u << 22)
__device__ __forceinline__ unsigned xb_ld(unsigned* p)              { return __hip_atomic_load(p, __ATOMIC_RELAXED, __HIP_MEMORY_SCOPE_AGENT); }
__device__ __forceinline__ unsigned xb_add(unsigned* p, unsigned v) { return __hip_atomic_fetch_add(p, v, __ATOMIC_RELAXED, __HIP_MEMORY_SCOPE_AGENT); }
__device__ __forceinline__ unsigned xb_xcc_id() { return (unsigned)__builtin_amdgcn_s_getreg((3 << 11) | 20) & 0xFu; }
#define XB_SPIN(cond, bar) do { unsigned _sp = 0; while (cond) { __builtin_amdgcn_s_sleep(1); \
    if ((++_sp & 255u) == 0u) { if (xb_ld(&(bar)[XB_TMO])) break; if (_sp > XB_SPIN_CAP) { atomicAdd(&(bar)[XB_TMO], 1u); break; } } } } while (0)
struct XcdBarrier { unsigned* bar; unsigned x; volatile LAS unsigned* st; };
__device__ __forceinline__ XcdBarrier xcd_barrier_post(unsigned* bar, volatile LAS unsigned* st) {
    XcdBarrier b; b.bar = bar; b.x = xb_xcc_id(); b.st = st;
    if (threadIdx.x == 0) (void)xb_add(&bar[XB_XCNT(b.x)], 1u);
    return b;
}
__device__ __forceinline__ void xcd_barrier_complete(unsigned* bar, unsigned x, unsigned& nloc, unsigned& nx) {
    const unsigned G = gridDim.x * gridDim.y * gridDim.z;
    unsigned sum, cnt, mine, sp = 0u;
    for (;;) {
        sum = 0u; cnt = 0u; mine = 0u;
#pragma unroll
        for (unsigned j = 0; j < 16; ++j) { const unsigned c = xb_ld(&bar[XB_XCNT(j)]); sum += c; cnt += (c > 0u) ? 1u : 0u; mine = (j == x) ? c : mine; }
        if (sum == G) break;
        __builtin_amdgcn_s_sleep(1);
        if ((++sp & 255u) == 0u) { if (xb_ld(&bar[XB_TMO])) break; if (sp > XB_SPIN_CAP) { atomicAdd(&bar[XB_TMO], 1u); break; } }
    }
    nloc = mine > 0u ? mine : 1u; nx = cnt > 0u ? cnt : 1u;
}
__device__ __forceinline__ void xcd_barrier(const XcdBarrier& b) {
    asm volatile("s_waitcnt vmcnt(0)" ::: "memory");
    __syncthreads();
    if (threadIdx.x == 0) {
        unsigned* bar = b.bar;
        __builtin_amdgcn_s_waitcnt(0);
        unsigned nloc = b.st[0], nx = b.st[1];
        if (nloc == 0u) { xcd_barrier_complete(bar, b.x, nloc, nx); b.st[0] = nloc; b.st[1] = nx; }
        const unsigned old = xb_add(&bar[XB_XSUB(b.x)], 1u);
        const unsigned gen = old / nloc;
        if (old + 1u == (gen + 1u) * nloc) {
            __builtin_amdgcn_fence(__ATOMIC_RELEASE, "agent");
            asm volatile("s_waitcnt vmcnt(0)" ::: "memory");
            const unsigned og = xb_add(&bar[XB_TOP], 1u);
            const unsigned tg = og / nx;
            if (og + 1u == (tg + 1u) * nx) xb_add(&bar[XB_TOPGEN], 1u);
            else XB_SPIN(xb_ld(&bar[XB_TOPGEN]) == tg, bar);
            __builtin_amdgcn_fence(__ATOMIC_ACQUIRE, "agent");
            xb_add(&bar[XB_XGEN(b.x)], 1u);
            asm volatile("s_waitcnt vmcnt(0)" ::: "memory");
        } else {
            XB_SPIN(xb_ld(&bar[XB_XGEN(b.x)]) == gen, bar);
            __builtin_amdgcn_fence(__ATOMIC_ACQUIRE, "agent");
            asm volatile("s_waitcnt vmcnt(0)" ::: "memory");
        }
    }
    __syncthreads();
}

namespace pg8 {
struct EpiProj {
    static constexpr bool PERM = true, AFTER_DRAIN = false;
    bf16_t* O; int ldc; const float* ssq;
    __device__ __forceinline__ void operator()(const f32x4 (&acc)[2][2][4][2], const Unit& u, int wr, int wc, int fr, int fq) const {
        const int row0 = u.pm * BM + wr * 64 + fr, col0 = u.pn * BM + wc * 32 + 8 * fq;
#pragma unroll
        for (int ai = 0; ai < 2; ++ai)
#pragma unroll
            for (int m = 0; m < 4; ++m) { const int row = row0 + ai * HALF + m * 16; const float rs = rsqrtf(ssq[row] * (1.0f / 1024.0f) + 1e-6f);
                bf16_t* rowp = O + (size_t)row * ldc + col0;
#pragma unroll
                for (int bj = 0; bj < 2; ++bj) { const f32x4 v0 = acc[ai][bj][m][0] * rs, v1 = acc[ai][bj][m][1] * rs;
                    u32x4 w; w.x = cvt_pk_bf16(v0[0], v0[1]); w.y = cvt_pk_bf16(v0[2], v0[3]); w.z = cvt_pk_bf16(v1[0], v1[1]); w.w = cvt_pk_bf16(v1[2], v1[3]);
                    *(u32x4*)(rowp + bj * HALF) = w; } }
    }
};
struct EpiOut {
    static constexpr bool PERM = false, AFTER_DRAIN = true;
    const float* xin; float* xout; bf16_t* xb; float* ssq; int write_xb;
    __device__ __forceinline__ void fused(const f32x4 (&acc)[2][2][4][2], const Unit& u, int wr, int wc, int fr, int fq) const {
        const int col0 = u.pn * BM + wc * 32 + 4 * fq;
#pragma unroll
        for (int ai = 0; ai < 2; ++ai)
#pragma unroll
            for (int m = 0; m < 4; ++m) { const int row = u.pm * BM + ai * HALF + wr * 64 + m * 16 + fr; const size_t off = (size_t)row * 1024 + col0; float s = 0.f;
#pragma unroll
                for (int bj = 0; bj < 2; ++bj)
#pragma unroll
                    for (int n = 0; n < 2; ++n) { const f32x4 o = *(const f32x4*)(xin + off + bj * HALF + n * 16) + acc[ai][bj][m][n];
                        *(f32x4*)(xout + off + bj * HALF + n * 16) = o; s += (o[0] * o[0] + o[1] * o[1]) + (o[2] * o[2] + o[3] * o[3]);
                        if (write_xb) { u32x2 w; w.x = cvt_pk_bf16(o[0], o[1]); w.y = cvt_pk_bf16(o[2], o[3]); *(u32x2*)(xb + off + bj * HALF + n * 16) = w; } }
                s += __shfl_xor(s, 16); s += __shfl_xor(s, 32);
                if (fq == 0) atomicAdd(ssq + row, s);
                asm volatile("" ::: "memory"); }
    }
};
}

struct Frame {
    LAS unsigned char* lds;
    volatile LAS unsigned* MISC;
    gu32* ctl;
    int tid, lane, wave, vcu, G;
    unsigned char* ws;
};
struct Args { const float* in[14]; float* out; unsigned char* ws; int ph_lo, ph_hi; };
enum { I_X = 0, I_NORMW, I_WIN, I_CONVW, I_CONVB, I_DTB, I_ALOG, I_SSDD, I_SSDNW, I_GATEW, I_GATEB, I_GLANW, I_WOUT, I_FINW };
#define WSP(F, off) ((bf16*)((F).ws + (off)))

__device__ __forceinline__ float wave_sum(float v) {
#pragma unroll
    for (int o = 1; o < 64; o <<= 1) v += __shfl_xor(v, o);
    return v;
}
__device__ __forceinline__ void cvt_win_item(const float* W, const float* nw, bf16* WT, LAS float* scr, int item, int lane) {
    const int nblk = PP / 32, kb = item / nblk, nb = item % nblk, k0 = 64 * kb, n0 = 32 * nb;
    const int n = n0 + (lane & 31); const bool valid = n < NPROJ; const int oc = valid ? proj_orig_col(n) : 0;
#pragma unroll 8
    for (int i = 0; i < 32; ++i) { const int kk = 2 * i + (lane >> 5); scr[kk * 33 + (lane & 31)] = valid ? W[(size_t)(k0 + kk) * NPROJ + oc] * nw[k0 + kk] : 0.f; }
    LDS_WAIT(); asm volatile("" ::: "memory");
    const int c = lane & 7;
#pragma unroll
    for (int j = 0; j < 4; ++j) { const int nn = (lane >> 3) + 8 * j; const LAS float* s = scr + (8 * c) * 33 + nn;
        v4u o; o.x = pk2(s[0 * 33], s[1 * 33]); o.y = pk2(s[2 * 33], s[3 * 33]); o.z = pk2(s[4 * 33], s[5 * 33]); o.w = pk2(s[6 * 33], s[7 * 33]);
        *(GAS v4u*)(WT + (size_t)(n0 + nn) * DM + k0 + 8 * c) = o; }
    LDS_WAIT(); asm volatile("" ::: "memory");
}
__device__ __forceinline__ void cvt_wout_item(const float* W, const float* snw, bf16* WT, LAS float* scr, int item, int lane) {
    const int nblk = DM / 32, kb = item / nblk, nb = item % nblk, k0 = 64 * kb, n0 = 32 * nb;
#pragma unroll 8
    for (int i = 0; i < 32; ++i) { const int kk = k0 + 2 * i + (lane >> 5); const float sc = kk < 1024 ? snw[kk] : 1.f;
        scr[(2 * i + (lane >> 5)) * 33 + (lane & 31)] = W[(size_t)wout_src_row(kk) * DM + n0 + (lane & 31)] * sc; }
    LDS_WAIT(); asm volatile("" ::: "memory");
    const int c = lane & 7;
#pragma unroll
    for (int j = 0; j < 4; ++j) { const int nn = (lane >> 3) + 8 * j; const LAS float* s = scr + (8 * c) * 33 + nn;
        v4u o; o.x = pk2(s[0 * 33], s[1 * 33]); o.y = pk2(s[2 * 33], s[3 * 33]); o.z = pk2(s[4 * 33], s[5 * 33]); o.w = pk2(s[6 * 33], s[7 * 33]);
        *(GAS v4u*)(WT + (size_t)(n0 + nn) * DI + k0 + 8 * c) = o; }
    LDS_WAIT(); asm volatile("" ::: "memory");
}
constexpr int CVT_WIN_ITEMS = (DM / 64) * (PP / 32);
constexpr int CVT_WOUT_ITEMS = (DI / 64) * (DM / 32);
__device__ __forceinline__ void row_to_bf16(const float* xrow, bf16* orow, float* ssq, int lane) {
    const GAS f32x4* xr = (const GAS f32x4*)xrow + lane;
    f32x4 v[4]; float s = 0.f;
#pragma unroll
    for (int j = 0; j < 4; ++j) { v[j] = xr[64 * j]; s += (v[j].x * v[j].x + v[j].y * v[j].y) + (v[j].z * v[j].z + v[j].w * v[j].w); }
    s = wave_sum(s);
    GAS unsigned long long* o8 = (GAS unsigned long long*)orow + lane;
#pragma unroll
    for (int j = 0; j < 4; ++j) o8[64 * j] = (unsigned long long)pk2(v[j].x, v[j].y) | ((unsigned long long)pk2(v[j].z, v[j].w) << 32);
    if (lane == 0) *ssq = s;
}
__device__ __forceinline__ void sb_naive_item(Frame& F, int item) {
    { int t_ = threadIdx.x; asm volatile("" : "+v"(t_)); F.tid = t_; F.lane = t_ & 63; }
    bf16* const PROJ = WSP(F, WS_PROJ);
    const int b = item >> 5, h = (item >> 2) & 7, t = (item & 3) * 512 + F.tid;
    const bf16* P = PROJ + (size_t)b * SEQ * PP;
    float q[64], o[64];
    { const v4u* qp = (const v4u*)(P + (size_t)t * PP + PC_SBQ + h * 64);
#pragma unroll
      for (int i = 0; i < 8; ++i) { const v4u w = qp[i];
          q[8 * i + 0] = bflo(w.x) * 0.125f; q[8 * i + 1] = bfhi(w.x) * 0.125f; q[8 * i + 2] = bflo(w.y) * 0.125f; q[8 * i + 3] = bfhi(w.y) * 0.125f;
          q[8 * i + 4] = bflo(w.z) * 0.125f; q[8 * i + 5] = bfhi(w.z) * 0.125f; q[8 * i + 6] = bflo(w.w) * 0.125f; q[8 * i + 7] = bfhi(w.w) * 0.125f; } }
#pragma unroll
    for (int d = 0; d < 64; ++d) o[d] = 0.f;
    float R = 1.f;
    for (int s = t - 1; s >= 0; --s) {
        const v4u* kp = (const v4u*)(P + (size_t)s * PP + PC_SBK + h * 64);
        const v4u* vp = (const v4u*)(P + (size_t)s * PP + PC_SBV + h * 64);
        float z = 0.f;
#pragma unroll
        for (int i = 0; i < 8; ++i) { const v4u w = kp[i];
            z += q[8 * i + 0] * bflo(w.x) + q[8 * i + 1] * bfhi(w.x) + q[8 * i + 2] * bflo(w.y) + q[8 * i + 3] * bfhi(w.y)
               + q[8 * i + 4] * bflo(w.z) + q[8 * i + 5] * bfhi(w.z) + q[8 * i + 6] * bflo(w.w) + q[8 * i + 7] * bfhi(w.w); }
        const float e = expf(-fabsf(z));
        const float big = 1.f / (1.f + e), small = e / (1.f + e);
        const float beta = z >= 0.f ? big : small, omb = z >= 0.f ? small : big;
        const float a = beta * R;
#pragma unroll
        for (int i = 0; i < 8; ++i) { const v4u w = vp[i];
            o[8 * i + 0] += a * bflo(w.x); o[8 * i + 1] += a * bfhi(w.x); o[8 * i + 2] += a * bflo(w.y); o[8 * i + 3] += a * bfhi(w.y);
            o[8 * i + 4] += a * bflo(w.z); o[8 * i + 5] += a * bfhi(w.z); o[8 * i + 6] += a * bflo(w.w); o[8 * i + 7] += a * bfhi(w.w); }
        R *= omb;
        if (R == 0.f) break;
    }
    bf16* zp = (bf16*)(P + (size_t)t * PP + PC_SBZ + h * 64);
#pragma unroll
    for (int i = 0; i < 8; ++i) { const v4u w = ((const v4u*)zp)[i]; v4u r;
        r.x = pk2(o[8 * i + 0] * siluf(bflo(w.x)), o[8 * i + 1] * siluf(bfhi(w.x))); r.y = pk2(o[8 * i + 2] * siluf(bflo(w.y)), o[8 * i + 3] * siluf(bfhi(w.y)));
        r.z = pk2(o[8 * i + 4] * siluf(bflo(w.z)), o[8 * i + 5] * siluf(bfhi(w.z))); r.w = pk2(o[8 * i + 6] * siluf(bflo(w.w)), o[8 * i + 7] * siluf(bfhi(w.w)));
        ((v4u*)zp)[i] = r; }
}

__device__ __forceinline__ void ssd_naive_item(Frame& F, const Args& args, int item, int layer) {
    { int t_ = threadIdx.x; asm volatile("" : "+v"(t_)); F.tid = t_; F.lane = t_ & 63; }
    const int b = item >> 1, g = item & 1, w = F.wave, p = F.lane, head = g * 8 + w, ch = g * 512 + w * 64 + p;
    bf16* P = WSP(F, WS_PROJ) + (size_t)b * SEQ * PP;
    LAS float* Bs = (LAS float*)(F.lds);
    LAS float* Cs = Bs + 16 * 128;
    LAS float* dts = Cs + 16 * 128;
    LAS float* red = dts + 128;
    LAS float* ybuf = red + 128;
    const float* cw = args.in[I_CONVW] + layer * 4 * 1536; const float* cb = args.in[I_CONVB] + layer * 1536;
    const float A = -expf(args.in[I_ALOG][layer * 16 + head]), Dk = args.in[I_SSDD][layer * 16 + head], dtb = args.in[I_DTB][layer * 16 + head];
    const float w0 = cw[0 * 1536 + ch], w1 = cw[1 * 1536 + ch], w2 = cw[2 * 1536 + ch], w3 = cw[3 * 1536 + ch], bb = cb[ch];
    float h[128];
#pragma unroll
    for (int n = 0; n < 128; ++n) h[n] = 0.f;
    float r1 = 0.f, r2 = 0.f, r3 = 0.f;
    for (int t0 = 0; t0 < SEQ; t0 += 16) {
        __syncthreads();
#pragma unroll
        for (int i = 0; i < 8; ++i) { const int e = F.tid + 512 * i, tok = e >> 8, cc = e & 255; const int xc = 1024 + (cc >> 7) * 256 + g * 128 + (cc & 127); const int t = t0 + tok;
            float acc = cb[xc];
#pragma unroll
            for (int k = 0; k < 4; ++k) { const int tt = t - 3 + k; if (tt >= 0) acc += cw[k * 1536 + xc] * bf2f(P[(size_t)tt * PP + PC_XBC + xc]); }
            const float v = siluf(acc); if (cc < 128) Bs[tok * 128 + cc] = v; else Cs[tok * 128 + (cc - 128)] = v; }
        if (F.tid < 128) { const int tok = F.tid >> 3, hh = F.tid & 7; dts[tok * 8 + hh] = softplusf(bf2f(P[(size_t)(t0 + tok) * PP + PC_DT + g * 8 + hh]) + args.in[I_DTB][layer * 16 + g * 8 + hh]); }
        __syncthreads();
#pragma unroll 1
        for (int r = 0; r < 16; ++r) {
            const int t = t0 + r;
            const float raw = bf2f(P[(size_t)t * PP + PC_XBC + ch]);
            const float xv = siluf(bb + w0 * r3 + w1 * r2 + w2 * r1 + w3 * raw);
            r3 = r2; r2 = r1; r1 = raw;
            const float dt = dts[r * 8 + w], dA = expf(dt * A), dx = dt * xv;
            float yy = 0.f;
#pragma unroll
            for (int n = 0; n < 128; ++n) { h[n] = dA * h[n] + dx * Bs[r * 128 + n]; yy += Cs[r * 128 + n] * h[n]; }
            yy += Dk * xv;
            const float z = bf2f(P[(size_t)t * PP + PC_SSDZ + ch]);
            const float yr = yy * siluf(z); ybuf[r * 512 + F.tid] = yr;
            const float s = wave_sum(yr * yr);
            if (p == 0) red[r * 8 + w] = s;
        }
        (void)dtb;
        __syncthreads();
#pragma unroll
        for (int r = 0; r < 16; ++r) { float s = 0.f;
#pragma unroll
            for (int j = 0; j < 8; ++j) s += red[r * 8 + j];
            P[(size_t)(t0 + r) * PP + PC_SSDZ + ch] = (bf16)f2bf(ybuf[r * 512 + F.tid] * rsqrtf(s * (1.f / 512.f) + EPS)); }
    }
}

__device__ __forceinline__ void gla_naive_item(Frame& F, const Args& args, int item, int layer) {
    { int t_ = threadIdx.x; asm volatile("" : "+v"(t_)); F.tid = t_; F.lane = t_ & 63; }
    const int b = item >> 2, h = item & 3, v = F.tid & 127, kq = F.tid >> 7;
    bf16* P = WSP(F, WS_PROJ) + (size_t)b * SEQ * PP;
    LAS float* qs = (LAS float*)(F.lds);
    LAS float* ks = qs + 1024;
    LAS float* gs = ks + 1024;
    LAS float* op = gs + 1024;
    const float* gw = args.in[I_GATEW] + layer * 16 * 256; const float* gb = args.in[I_GATEB] + layer * 256; const float* nw = args.in[I_GLANW] + layer * 128;
    float S[16];
#pragma unroll
    for (int k = 0; k < 16; ++k) S[k] = 0.f;
    for (int t0 = 0; t0 < SEQ; t0 += 16) {
        __syncthreads();
#pragma unroll
        for (int i = 0; i < 2; ++i) { const int e = F.tid + 512 * i, tok = e >> 6, k = e & 63; const bf16* row = P + (size_t)(t0 + tok) * PP;
            float a = gb[h * 64 + k];
#pragma unroll
            for (int r = 0; r < 16; ++r) a += bf2f(row[PC_GLR + r]) * gw[r * 256 + h * 64 + k];
            gs[tok * 64 + k] = expf(logsigf(a) * (1.f / 16.f));
            qs[tok * 64 + k] = bf2f(row[PC_GQ + h * 64 + k]) * 0.125f;
            ks[tok * 64 + k] = bf2f(row[PC_GK + h * 64 + k]); }
        __syncthreads();
#pragma unroll 1
        for (int r = 0; r < 16; ++r) {
            const float vv = bf2f(P[(size_t)(t0 + r) * PP + PC_GV + h * 128 + v]);
            float o = 0.f;
#pragma unroll
            for (int kk = 0; kk < 16; ++kk) { const int k = kq * 16 + kk; S[kk] = gs[r * 64 + k] * S[kk] + ks[r * 64 + k] * vv; o += qs[r * 64 + k] * S[kk]; }
            op[(kq * 16 + r) * 128 + v] = o;
        }
        __syncthreads();
        { const int tok = F.tid >> 5, vv = F.tid & 31; float oj[4]; float s = 0.f;
#pragma unroll
          for (int j = 0; j < 4; ++j) { const int vj = vv + 32 * j; oj[j] = op[(0 * 16 + tok) * 128 + vj] + op[(1 * 16 + tok) * 128 + vj] + op[(2 * 16 + tok) * 128 + vj] + op[(3 * 16 + tok) * 128 + vj]; s += oj[j] * oj[j]; }
          s += __shfl_xor(s, 1); s += __shfl_xor(s, 2); s += __shfl_xor(s, 4); s += __shfl_xor(s, 8); s += __shfl_xor(s, 16);
          const float rs = rsqrtf(s * (1.f / 128.f) + EPS);
          bf16* row = P + (size_t)(t0 + tok) * PP + PC_GZ + h * 128;
#pragma unroll
          for (int j = 0; j < 4; ++j) { const int vj = vv + 32 * j; const float z = bf2f(row[vj]); row[vj] = (bf16)f2bf(oj[j] * rs * nw[vj] * siluf(z)); } }
    }
}
#ifndef MK_N_LAUNCHES
#define MK_N_LAUNCHES 1
#endif
constexpr int N_PHASES = 8;

__device__ __forceinline__ void p0_prologue(Frame& F, const Args& args) {
    LAS float* scr = (LAS float*)(F.lds + RING_OFF + F.wave * 16384);
    const int gw = F.vcu * NWAVES + F.wave, NGW = F.G * NWAVES;
    constexpr int NITEMS = CVT_WIN_ITEMS + CVT_WOUT_ITEMS;
    for (int it = gw; it < NITEMS; it += NGW) {
        if (it < CVT_WIN_ITEMS) cvt_win_item(args.in[I_WIN], args.in[I_NORMW], WSP(F, WS_WIN), scr, it, F.lane);
        else cvt_wout_item(args.in[I_WOUT], args.in[I_SSDNW], WSP(F, WS_WOUT), scr, it - CVT_WIN_ITEMS, F.lane);
    }
    float* ssq0 = (float*)(F.ctl + CW_SSQX);
    for (int m = gw; m < T; m += NGW) row_to_bf16(args.in[I_X] + (size_t)m * DM, WSP(F, WS_XB) + (size_t)m * DM, ssq0 + m, F.lane);
}

__device__ __forceinline__ void p_mixers(Frame& F, const Args& args, int layer) {
    constexpr int N_SSD = 16, N_GLA = 32, N_SB = 256;
    const int ncv = (layer == 0) ? CVT_WIN_ITEMS / 8 : CVT_WOUT_ITEMS / 8;
    const int total = N_SSD + N_GLA + N_SB + ncv;
    for (;;) {
        __syncthreads();
        if (F.tid == 0) F.MISC[16] = __hip_atomic_fetch_add((unsigned*)(F.ctl + CW_Q + 64 * layer), 1u, RLX_AGENT);
        __syncthreads();
        int item = (int)F.MISC[16];
        if (item >= total) break;
        if (item < N_SSD) { ssd_naive_item(F, args, item, layer); continue; } item -= N_SSD;
        if (item < N_GLA) { gla_naive_item(F, args, item, layer); continue; } item -= N_GLA;
        if (item < N_SB) { sb_naive_item(F, item); continue; } item -= N_SB;
        LAS float* scr = (LAS float*)(F.lds + RING_OFF + F.wave * 16384);
        if (layer == 0) cvt_win_item(args.in[I_WIN] + (size_t)DM * NPROJ, args.in[I_NORMW] + DM, WSP(F, WS_WIN), scr, item * 8 + F.wave, F.lane);
        else cvt_wout_item(args.in[I_WOUT] + (size_t)DI * DM, args.in[I_SSDNW] + 1024, WSP(F, WS_WOUT), scr, item * 8 + F.wave, F.lane);
    }
}

__global__ void __launch_bounds__(NWAVES * 64, 2) mk_fwd(Args args) {
    extern __shared__ __attribute__((aligned(16))) unsigned char lds[];
    Frame F;
    F.lds = (LAS unsigned char*)lds;
    F.MISC = (volatile LAS unsigned*)(F.lds + MISC_OFF);
    F.tid = threadIdx.x; F.lane = F.tid & 63; F.wave = __builtin_amdgcn_readfirstlane(F.tid >> 6);
    F.G = gridDim.x; { const int bx = blockIdx.x; F.vcu = (F.G % 8 == 0) ? (bx % 8) * (F.G / 8) + bx / 8 : bx; }
    F.ws = args.ws;
    F.ctl = (gu32*)(F.ws + WS_CTL);
    for (int u = F.tid; u < (LDS_BYTES - LDSCTL_OFF) / 4; u += NWAVES * 64) ((LAS unsigned*)(F.lds + LDSCTL_OFF))[u] = 0u;
    __syncthreads();
    XcdBarrier bar; bar.bar = (unsigned*)(F.ctl + CW_BAR); bar.x = 0; bar.st = nullptr;
    if (MK_N_LAUNCHES == 1) bar = xcd_barrier_post((unsigned*)(F.ctl + CW_BAR), F.MISC + 8);
#define GRID_BAR() do { if (MK_N_LAUNCHES == 1) xcd_barrier(bar); } while (0)
    const int lo = args.ph_lo, hi = args.ph_hi;
#define IN(k) (lo <= (k) && (k) < hi)
    if (IN(0)) { p0_prologue(F, args); GRID_BAR(); }
#pragma unroll 1
    for (int layer = 0; layer < DEPTH; ++layer) {
        float* ssq_in = (float*)(F.ctl + CW_SSQX) + layer * T;
        float* ssq_next = ssq_in + T;
        if (IN(1 + 3 * layer)) {
            pg8::Gemm g{WSP(F, WS_XB), WSP(F, WS_WIN), T, PP, DM, DM}; pg8::StaticOrder S; S.init(T, PP, F.G, (int)blockIdx.x);
            pg8::EpiProj E{WSP(F, WS_PROJ), PP, ssq_in};
            pg8::gemm_phase<pg8::EpiProj, true, false, DM, DM>(F.lds + RING_OFF, g, S, E, nullptr);
            GRID_BAR();
        }
        if (IN(2 + 3 * layer)) { p_mixers(F, args, layer); GRID_BAR(); }
        if (IN(3 + 3 * layer)) {
            pg8::Gemm g{WSP(F, WS_PROJ) + PC_Y, WSP(F, WS_WOUT), T, DM, DI, PP}; pg8::StaticOrder S; S.init(T, DM, F.G, (int)blockIdx.x);
            LAS float* hsc = (LAS float*)(F.lds + HSC_OFF);
            { pg8::Unit u; if (S.next(0, u) && F.tid < 256) { hsc[F.tid * 2 + 0] = 1.f; hsc[F.tid * 2 + 1] = 1.f; } }
            VM_WAIT(); __syncthreads();
            pg8::EpiOut E{layer == 0 ? args.in[I_X] : args.out, args.out, WSP(F, WS_XB), ssq_next, layer == 0 ? 1 : 0};
            pg8::gemm_phase<pg8::EpiOut, false, true, DI, PP>(F.lds + RING_OFF, g, S, E, hsc);
            GRID_BAR();
        }
    }
    if (IN(7)) {
        const float* ssq2 = (const float*)(F.ctl + CW_SSQX) + 2 * T;
        const int gw = F.vcu * NWAVES + F.wave, NGW = F.G * NWAVES;
        for (int m = gw; m < T; m += NGW) {
            const float rs = rsqrtf(ssq2[m] * (1.f / 1024.f) + EPS);
            GAS f32x4* xr = (GAS f32x4*)(args.out + (size_t)m * DM) + F.lane; const GAS f32x4* wr_ = (const GAS f32x4*)args.in[I_FINW] + F.lane;
#pragma unroll
            for (int j = 0; j < 4; ++j) { f32x4 v = xr[64 * j]; const f32x4 w = wr_[64 * j]; v = v * rs * w; xr[64 * j] = v; }
        }
    }
#undef IN
#undef GRID_BAR
}

extern "C" void kernel_launch(void* const* d_in, const int* in_sizes, int n_in, void* d_out, int out_size, void* d_ws, size_t ws_size, hipStream_t stream) {
    static int grid = 0;
    if (grid == 0) {
        if (n_in != 14 || in_sizes[0] != T * DM || out_size != T * DM || ws_size < WS_END) { fprintf(stderr, "kernel_launch: unexpected shapes (n_in %d in0 %d out %d ws %zu)\n", n_in, n_in > 0 ? in_sizes[0] : -1, out_size, ws_size); grid = -1; return; }
        int dev = 0, cus = 0, per_cu = 0;
        if (hipGetDevice(&dev) != hipSuccess || hipDeviceGetAttribute(&cus, hipDeviceAttributeMultiprocessorCount, dev) != hipSuccess) { grid = -1; return; }
        if (hipFuncSetAttribute((const void*)mk_fwd, hipFuncAttributeMaxDynamicSharedMemorySize, LDS_BYTES) != hipSuccess) { fprintf(stderr, "kernel_launch: hipFuncSetAttribute failed\n"); grid = -1; return; }
        if (hipOccupancyMaxActiveBlocksPerMultiprocessor(&per_cu, (const void*)mk_fwd, NWAVES * 64, LDS_BYTES) != hipSuccess || per_cu < 1) { fprintf(stderr, "kernel_launch: occupancy query says %d blocks/CU\n", per_cu); }
        (void)hipGetLastError();
        grid = cus;
        if (grid != 256) fprintf(stderr, "kernel_launch: %d CUs (expected 256)\n", grid);
    }
    if (grid < 0) return;
    (void)hipMemsetAsync((char*)d_ws + WS_CTL, 0, CTL_ZERO_BYTES, stream);
    Args a{};
    for (int i = 0; i < 14; ++i) a.in[i] = (const float*)d_in[i];
    a.out = (float*)d_out; a.ws = (unsigned char*)d_ws;
    if (MK_N_LAUNCHES == 1) { a.ph_lo = 0; a.ph_hi = N_PHASES; hipLaunchKernelGGL(mk_fwd, dim3(grid), dim3(NWAVES * 64), LDS_BYTES, stream, a); }
    else for (int p = 0; p < N_PHASES; ++p) { a.ph_lo = p; a.ph_hi = p + 1; hipLaunchKernelGGL(mk_fwd, dim3(grid), dim3(NWAVES * 64), LDS_BYTES, stream, a); }
}
```

```cpp
#include <hip/hip_runtime.h>
#include <cstdio>
#include <cstdint>
namespace pg8 {
#define PG8_LAS __attribute__((address_space(3)))
typedef unsigned short bf16_t;
typedef short bf16x8 __attribute__((ext_vector_type(8)));
typedef float f32x4 __attribute__((ext_vector_type(4)));
typedef unsigned u32x4 __attribute__((ext_vector_type(4)));
typedef unsigned u32x2 __attribute__((ext_vector_type(2)));
constexpr int BM = 256, BK = 64, HALF = 128, HTB = HALF * BK * 2  , STAGE_BYTES = 8 * HTB, NXCD = 8, WGM = 8;

__host__ __device__ __forceinline__ int lds_byte(int r, int c) { const int st = (r >> 4) * 2 + (c >> 5), rr = r & 15, cc = c & 31, ob = rr * 64 + cc * 2; return st * 1024 + (ob ^ (((ob >> 9) & 1) << 5)); }
__host__ __device__ __forceinline__ void stage_rc(int b, int& R, int& C) { const int st = b / 1024, sb = b % 1024, swz = sb ^ (((sb >> 9) & 1) << 5); R = (st >> 1) * 16 + swz / 64; C = (st & 1) * 32 + (swz % 64) / 2; }
__host__ __device__ __forceinline__ int perm32(int rho) { const int n = rho >> 4, i = rho & 15; return 8 * (i >> 2) + 4 * n + (i & 3); }

struct Unit { int pm, pn; };
struct Gemm { const bf16_t* A; const bf16_t* Bt; int M, N, K, lda; };

struct StaticOrder {
    int nM, nN, nwg, G, c;
    __host__ __device__ void init(int M, int N, int G_, int c_) { nM = M / BM; nN = N / BM; nwg = nM * nN; G = G_; c = c_; }
    __host__ __device__ bool next(int i, Unit& u) const {
        const long L = (long)i * G + c; if (L >= nwg) return false;
        int wgid = (int)L; { const int q = nwg / NXCD, r = nwg % NXCD, xcd = wgid % NXCD, off = wgid / NXCD; wgid = (xcd < r ? xcd * (q + 1) : r * (q + 1) + (xcd - r) * q) + off; }
        const int nig = WGM * nN, gid = wgid / nig, fm = gid * WGM, gsz = (nM - fm) < WGM ? (nM - fm) : WGM;
        u.pm = fm + ((wgid % nig) % gsz); u.pn = (wgid % nig) / gsz; return true;
    }
};

__device__ __forceinline__ unsigned cvt_pk_bf16(float lo, float hi) { unsigned r; asm volatile("v_cvt_pk_bf16_f32 %0, %1, %2" : "=v"(r) : "v"(lo), "v"(hi)); return r; }

template <class Epi, bool ALIGN_EPI, bool HORNER, int K, int lda>
__device__ __forceinline__ void gemm_phase(PG8_LAS unsigned char* lds, const Gemm g, const StaticOrder& S, const Epi& E, const PG8_LAS float* hsc) {
    int tid_ = threadIdx.x; asm volatile("" : "+v"(tid_));
    const int tid = tid_, wid = __builtin_amdgcn_readfirstlane(tid >> 6), lane = tid & 63, wr = wid >> 2, wc = wid & 3, fr = lane & 15, fq = lane >> 4;
    constexpr int nt = K / BK;
    unsigned voffA[2], voffB[2];
#pragma unroll
    for (int i = 0; i < 2; ++i) { int R, C; stage_rc(tid * 16 + i * 8192, R, C); const int Rb = Epi::PERM ? ((R & ~31) + perm32(R & 31)) : R;
        voffA[i] = (unsigned)(R * lda + C) * 2u; voffB[i] = (unsigned)(Rb * K + C) * 2u; }
    constexpr size_t kstep = (size_t)(BK * 2);
    constexpr size_t hstepA = (size_t)HALF * lda * 2, hstepB = (size_t)HALF * K * 2;
    constexpr size_t tstepA = 2 * hstepA, tstepB = 2 * hstepB;
    const unsigned ldsw = (unsigned)wid * 1024u;
    const int aoff = lds_byte(wr * 64 + fr, fq * 8), boff = lds_byte(wc * 32 + fr, fq * 8);
#define PG8_SA(b, h) (((b) * 2 + (h)) * HTB)
#define PG8_SB(b, h) ((4 + (b) * 2 + (h)) * HTB)
#define PG8_STAGE(bufoff, gbase, voff) do { _Pragma("unroll") for (int _i = 0; _i < 2; ++_i) \
        __builtin_amdgcn_global_load_lds((const unsigned*)((const char*)(gbase) + (voff)[_i]), (PG8_LAS unsigned*)(lds + (bufoff) + ldsw + _i * 8192), 16, 0, 0); } while (0)
#define PG8_LDA(dst, b, h) do { _Pragma("unroll") for (int m = 0; m < 4; ++m) _Pragma("unroll") for (int k = 0; k < 2; ++k) dst[m][k] = *(const PG8_LAS bf16x8*)(lds + PG8_SA(b, h) + aoff + m * 2048 + k * 1024); } while (0)
#define PG8_LDB(dst, b, h) do { _Pragma("unroll") for (int n = 0; n < 2; ++n) _Pragma("unroll") for (int k = 0; k < 2; ++k) dst[n][k] = *(const PG8_LAS bf16x8*)(lds + PG8_SB(b, h) + boff + n * 2048 + k * 1024); } while (0)
#define PG8_MMA(ai, bj, At, Bt) do { __builtin_amdgcn_s_setprio(1); _Pragma("unroll") for (int m = 0; m < 4; ++m) _Pragma("unroll") for (int n = 0; n < 2; ++n) _Pragma("unroll") for (int k = 0; k < 2; ++k) \
        acc[ai][bj][m][n] = __builtin_amdgcn_mfma_f32_16x16x32_bf16(Bt[n][k], At[m][k], acc[ai][bj][m][n], 0, 0, 0); __builtin_amdgcn_s_setprio(0); } while (0)
#define PG8_WAIT_V(n) asm volatile("s_waitcnt vmcnt(" #n ")" ::: "memory")
#define PG8_WAIT_L(n) asm volatile("s_waitcnt lgkmcnt(" #n ")" ::: "memory")
#define PG8_BAR __builtin_amdgcn_s_barrier()
#define PG8_SCHED __builtin_amdgcn_sched_barrier(0)
    Unit cur, nxt; int ui = 0;
    if (!S.next(0, cur)) return;
    f32x4 acc[2][2][4][2];
#pragma unroll
    for (int a = 0; a < 2; ++a)
#pragma unroll
        for (int b = 0; b < 2; ++b)
#pragma unroll
            for (int m = 0; m < 4; ++m)
#pragma unroll
                for (int n = 0; n < 2; ++n) acc[a][b][m][n] = (f32x4){0.f, 0.f, 0.f, 0.f};
    bf16x8 At[4][2], B0[2][2], B1[2][2];
    const char* cA = (const char*)g.A + (size_t)cur.pm * tstepA; const char* cB = (const char*)g.Bt + (size_t)cur.pn * tstepB;
    PG8_STAGE(PG8_SB(0, 0), cB, voffB); PG8_STAGE(PG8_SB(0, 1), cB + hstepB, voffB); PG8_STAGE(PG8_SA(0, 0), cA, voffA); PG8_STAGE(PG8_SA(0, 1), cA + hstepA, voffA);
    if (wr == 1) PG8_BAR;
    PG8_WAIT_V(2); PG8_BAR;
    PG8_STAGE(PG8_SB(1, 0), cB + kstep, voffB); PG8_STAGE(PG8_SA(1, 0), cA + kstep, voffA); PG8_STAGE(PG8_SB(1, 1), cB + hstepB + kstep, voffB);
    PG8_WAIT_V(6); PG8_BAR;
    for (;;) {
        const bool has_next = S.next(ui + 1, nxt);
        const char* nA = has_next ? (const char*)g.A + (size_t)nxt.pm * tstepA : cA; const char* nB = has_next ? (const char*)g.Bt + (size_t)nxt.pn * tstepB : cB;
        for (int t = 0; t < nt; t += 2) {
            const bool last = (t == nt - 2);
            const char* a1 = cA + (size_t)(t + 1) * kstep;
            const char* a2 = last ? nA : cA + (size_t)(t + 2) * kstep; const char* b2 = last ? nB : cB + (size_t)(t + 2) * kstep;
            const char* a3 = a2 + kstep; const char* b3 = b2 + kstep;
            if constexpr (HORNER) {
                if (t == 8 || t == 16) { const int hc = (t == 8) ? 0 : 1;
#pragma unroll
                    for (int ai = 0; ai < 2; ++ai)
#pragma unroll
                        for (int m = 0; m < 4; ++m) { const float f = hsc[(ai * HALF + wr * 64 + m * 16 + fr) * 2 + hc];
#pragma unroll
                            for (int bj = 0; bj < 2; ++bj)
#pragma unroll
                                for (int n = 0; n < 2; ++n) acc[ai][bj][m][n] = acc[ai][bj][m][n] * f; }
                    PG8_WAIT_L(0); PG8_SCHED; }
            }
            PG8_LDB(B0, 0, 0); PG8_LDB(B1, 0, 1); PG8_SCHED; PG8_LDA(At, 0, 0); PG8_STAGE(PG8_SA(1, 1), a1 + hstepA, voffA);
            PG8_WAIT_V(8); PG8_WAIT_L(0); PG8_BAR; PG8_MMA(0, 0, At, B0); PG8_MMA(0, 1, At, B1); PG8_BAR; PG8_SCHED;
            PG8_LDA(At, 0, 1); PG8_STAGE(PG8_SB(0, 0), b2, voffB); PG8_STAGE(PG8_SB(0, 1), b2 + hstepB, voffB); PG8_STAGE(PG8_SA(0, 0), a2, voffA);
            PG8_WAIT_V(8); PG8_WAIT_L(0); PG8_BAR; PG8_MMA(1, 0, At, B0); PG8_MMA(1, 1, At, B1); PG8_BAR; PG8_SCHED;
            PG8_LDB(B0, 1, 0); PG8_LDB(B1, 1, 1); PG8_SCHED; PG8_LDA(At, 1, 0); PG8_STAGE(PG8_SA(0, 1), a2 + hstepA, voffA);
            PG8_WAIT_V(8); PG8_WAIT_L(0); PG8_BAR; PG8_MMA(0, 0, At, B0); PG8_MMA(0, 1, At, B1); PG8_BAR; PG8_SCHED;
            PG8_LDA(At, 1, 1); PG8_STAGE(PG8_SB(1, 0), b3, voffB); PG8_STAGE(PG8_SB(1, 1), b3 + hstepB, voffB); PG8_STAGE(PG8_SA(1, 0), a3, voffA);
            PG8_WAIT_V(8); PG8_WAIT_L(0); PG8_BAR; PG8_MMA(1, 0, At, B0); PG8_MMA(1, 1, At, B1); PG8_BAR; PG8_SCHED;
        }
        if constexpr (ALIGN_EPI) { if (wr == 0) PG8_BAR; }
        if constexpr (!Epi::AFTER_DRAIN) { E(acc, cur, wr, wc, fr, fq); }
        if (!has_next) break;
#pragma unroll
        for (int a = 0; a < 2; ++a)
#pragma unroll
            for (int b = 0; b < 2; ++b)
#pragma unroll
                for (int m = 0; m < 4; ++m)
#pragma unroll
                    for (int n = 0; n < 2; ++n) acc[a][b][m][n] = (f32x4){0.f, 0.f, 0.f, 0.f};
        cur = nxt; cA = nA; cB = nB; ++ui;
        if constexpr (ALIGN_EPI) { if (wr == 1) PG8_BAR; }
    }
    PG8_WAIT_V(0);
    if constexpr (!ALIGN_EPI) { if (wr == 0) PG8_BAR; }
    PG8_BAR;
    if constexpr (Epi::AFTER_DRAIN) { E.fused(acc, cur, wr, wc, fr, fq); }
#undef PG8_SA
#undef PG8_SB
#undef PG8_STAGE
#undef PG8_LDA
#undef PG8_LDB
#undef PG8_MMA
#undef PG8_WAIT_V
#undef PG8_WAIT_L
#undef PG8_BAR
#undef PG8_SCHED
}
}
#ifndef MK_PROBE
#define MK_PROBE 0
#endif
constexpr int NWAVES = 8;
constexpr int BATCH = 8, SEQ = 2048, T = BATCH * SEQ, DM = 1024, DEPTH = 2;
constexpr int NPROJ = 6176, PP = 6400  , DI = 2048;
constexpr float EPS = 1e-6f;
constexpr int PC_Y = 0;
constexpr int PC_SSDZ = 0, PC_SBZ = 1024, PC_GZ = 1536;
constexpr int PC_SBQ = 2048, PC_SBK = 2560, PC_SBV = 3072;
constexpr int PC_XBC = 3584  , PC_DT = 5120, PC_GQ = 5136, PC_GK = 5392, PC_GV = 5648, PC_GLR = 6160;
__host__ __device__ __forceinline__ int proj_orig_col(int n) {
    if (n < 1024) return 2048 + n;
    if (n < 1536) return 1536 + (n - 1024);
    if (n < 2048) return 5648 + (n - 1536);
    if (n < 3584) return n - 2048;
    if (n < 5136) return 3072 + (n - 3584);
    if (n < 6160) return n - 512;
    return n;
}
__host__ __device__ __forceinline__ int wout_src_row(int kk) { return kk < 1024 ? 512 + kk : (kk < 1536 ? kk - 1024 : kk); }

constexpr size_t MiB = 1u << 20;
constexpr size_t WS_CTL = 0, CTL_ZERO_BYTES = 1 * MiB;
constexpr size_t WS_WIN = 1 * MiB;
constexpr size_t WS_WOUT = 14 * MiB;
constexpr size_t WS_XB = 18 * MiB;
constexpr size_t WS_PROJ = 50 * MiB;
constexpr size_t WS_END = 250 * MiB;
static_assert(WS_WIN + (size_t)PP * DM * 2 <= WS_WOUT && WS_WOUT + (size_t)DM * DI * 2 <= WS_XB && WS_XB + (size_t)T * DM * 2 <= WS_PROJ && WS_PROJ + (size_t)T * PP * 2 <= WS_END, "ws map");
constexpr int CW_TMO = 0, CW_CODE = 1;
constexpr int CW_BAR = 4096;
constexpr int CW_TS = 6144;
constexpr int CW_Q = 8192;
constexpr int CW_SSQX = 32768;
constexpr int CW_SSQG = CW_SSQX + 3 * T;
static_assert((CW_SSQG + 2 * T * 2) * 4 <= (int)CTL_ZERO_BYTES, "CTL");

constexpr int RING_OFF = 0, RING_BYTES = 131072;
constexpr int HSC_OFF = RING_BYTES;
constexpr int LDSCTL_OFF = HSC_OFF + 2048, MISC_OFF = LDSCTL_OFF + 320;
constexpr int LDS_BYTES = 147456;
static_assert(MISC_OFF + 128 <= LDS_BYTES, "LDS map");

#define GAS __attribute__((address_space(1)))
#define LAS __attribute__((address_space(3)))
typedef unsigned short bf16;
typedef unsigned v4u __attribute__((ext_vector_type(4)));
typedef unsigned v2u __attribute__((ext_vector_type(2)));
typedef float f32x4 __attribute__((ext_vector_type(4)));
typedef GAS unsigned gu32;
#define RLX_AGENT __ATOMIC_RELAXED, __HIP_MEMORY_SCOPE_AGENT
#define LDS_WAIT() asm volatile("s_waitcnt lgkmcnt(0)" ::: "memory")
#define VM_WAIT() asm volatile("s_waitcnt vmcnt(0)" ::: "memory")
__device__ __forceinline__ unsigned f2bf(float f) { unsigned u = __builtin_bit_cast(unsigned, f); return (u + 0x7fffu + ((u >> 16) & 1u)) >> 16; }
__device__ __forceinline__ unsigned pk2(float lo, float hi) { return f2bf(lo) | (f2bf(hi) << 16); }
__device__ __forceinline__ float bf2f(bf16 v) { return __builtin_bit_cast(float, (unsigned)v << 16); }
__device__ __forceinline__ float bflo(unsigned w) { return __builtin_bit_cast(float, w << 16); }
__device__ __forceinline__ float bfhi(unsigned w) { return __builtin_bit_cast(float, w & 0xffff0000u); }
__device__ __forceinline__ float siluf(float x) { return x / (1.f + __expf(-x)); }
__device__ __forceinline__ float softplusf(float x) { return fmaxf(x, 0.f) + log1pf(expf(-fabsf(x))); }
__device__ __forceinline__ float logsigf(float x) { return fminf(x, 0.f) - log1pf(expf(-fabsf(x))); }

#define XB_TMO      128
#define XB_XCNT(j)  (256  + 64 * (j))
#define XB_XSUB(j)  (1280 + 64 * (j))
#define XB_XGEN(j)  (2304 + 64 * (j))
#define XB_TOP      3328
#define XB_TOPGEN   3392
#define XCD_BAR_WORDS 3456
#define XB_SPIN_CAP (1u << 22)
__device__ __forceinline__ unsigned xb_ld(unsigned* p)              { return __hip_atomic_load(p, __ATOMIC_RELAXED, __HIP_MEMORY_SCOPE_AGENT); }
__device__ __forceinline__ unsigned xb_add(unsigned* p, unsigned v) { return __hip_atomic_fetch_add(p, v, __ATOMIC_RELAXED, __HIP_MEMORY_SCOPE_AGENT); }
__device__ __forceinline__ unsigned xb_xcc_id() { return (unsigned)__builtin_amdgcn_s_getreg((3 << 11) | 20) & 0xFu; }
#define XB_SPIN(cond, bar) do { unsigned _sp = 0; while (cond) { __builtin_amdgcn_s_sleep(1); \
    if ((++_sp & 255u) == 0u) { if (xb_ld(&(bar)[XB_TMO])) break; if (_sp > XB_SPIN_CAP) { atomicAdd(&(bar)[XB_TMO], 1u); break; } } } } while (0)
struct XcdBarrier { unsigned* bar; unsigned x; volatile LAS unsigned* st; };
__device__ __forceinline__ XcdBarrier xcd_barrier_post(unsigned* bar, volatile LAS unsigned* st) {
    XcdBarrier b; b.bar = bar; b.x = xb_xcc_id(); b.st = st;
    if (threadIdx.x == 0) (void)xb_add(&bar[XB_XCNT(b.x)], 1u);
    return b;
}
__device__ __forceinline__ void xcd_barrier_complete(unsigned* bar, unsigned x, unsigned& nloc, unsigned& nx) {
    const unsigned G = gridDim.x * gridDim.y * gridDim.z;
    unsigned sum, cnt, sp = 0u;
    for (;;) {
        sum = 0u; cnt = 0u;
#pragma unroll 1
        for (unsigned j = 0; j < 16; ++j) { const unsigned c = xb_ld(&bar[XB_XCNT(j)]); sum += c; cnt += (c > 0u) ? 1u : 0u; }
        if (sum == G) break;
        __builtin_amdgcn_s_sleep(1);
        if ((++sp & 255u) == 0u) { if (xb_ld(&bar[XB_TMO])) break; if (sp > XB_SPIN_CAP) { atomicAdd(&bar[XB_TMO], 1u); break; } }
    }
    const unsigned mine = xb_ld(&bar[XB_XCNT(x)]);
    nloc = mine > 0u ? mine : 1u; nx = cnt > 0u ? cnt : 1u;
}
template <bool FIRST> __device__ __forceinline__ void xcd_barrier(const XcdBarrier& b) {
    asm volatile("s_waitcnt vmcnt(0)" ::: "memory");
    __syncthreads();
    if (threadIdx.x == 0) {
        unsigned* bar = b.bar;
        __builtin_amdgcn_s_waitcnt(0);
        unsigned nloc = b.st[0], nx = b.st[1];
        if constexpr (FIRST) { if (nloc == 0u) { xcd_barrier_complete(bar, b.x, nloc, nx); b.st[0] = nloc; b.st[1] = nx; } }
        const unsigned old = xb_add(&bar[XB_XSUB(b.x)], 1u);
        const unsigned gen = old / nloc;
        if (old + 1u == (gen + 1u) * nloc) {
            __builtin_amdgcn_fence(__ATOMIC_RELEASE, "agent");
            asm volatile("s_waitcnt vmcnt(0)" ::: "memory");
            const unsigned og = xb_add(&bar[XB_TOP], 1u);
            const unsigned tg = og / nx;
            if (og + 1u == (tg + 1u) * nx) xb_add(&bar[XB_TOPGEN], 1u);
            else XB_SPIN(xb_ld(&bar[XB_TOPGEN]) == tg, bar);
            __builtin_amdgcn_fence(__ATOMIC_ACQUIRE, "agent");
            xb_add(&bar[XB_XGEN(b.x)], 1u);
            asm volatile("s_waitcnt vmcnt(0)" ::: "memory");
        } else {
            XB_SPIN(xb_ld(&bar[XB_XGEN(b.x)]) == gen, bar);
            __builtin_amdgcn_fence(__ATOMIC_ACQUIRE, "agent");
            asm volatile("s_waitcnt vmcnt(0)" ::: "memory");
        }
    }
    __syncthreads();
}

namespace pg8 {
struct EpiProj {
    static constexpr bool PERM = true, AFTER_DRAIN = false;
    bf16_t* O; int ldc; const float* ssq;
    __device__ __forceinline__ void operator()(const f32x4 (&acc)[2][2][4][2], const Unit& u, int wr, int wc, int fr, int fq) const {
        const int row0 = u.pm * BM + wr * 64 + fr, col0 = u.pn * BM + wc * 32 + 8 * fq;
#pragma unroll
        for (int ai = 0; ai < 2; ++ai)
#pragma unroll
            for (int m = 0; m < 4; ++m) { const int row = row0 + ai * HALF + m * 16; const float rs = rsqrtf(ssq[row] * (1.0f / 1024.0f) + 1e-6f);
                bf16_t* rowp = O + (size_t)row * ldc + col0;
#pragma unroll
                for (int bj = 0; bj < 2; ++bj) { const f32x4 v0 = acc[ai][bj][m][0] * rs, v1 = acc[ai][bj][m][1] * rs;
                    u32x4 w; w.x = cvt_pk_bf16(v0[0], v0[1]); w.y = cvt_pk_bf16(v0[2], v0[3]); w.z = cvt_pk_bf16(v1[0], v1[1]); w.w = cvt_pk_bf16(v1[2], v1[3]);
                    *(u32x4*)(rowp + bj * HALF) = w; } }
    }
};
struct EpiOut {
    static constexpr bool PERM = false, AFTER_DRAIN = true;
    const float* xin; float* xout; bf16_t* xb; float* ssq; int write_xb;
    __device__ __forceinline__ void fused(const f32x4 (&acc)[2][2][4][2], const Unit& u, int wr, int wc, int fr, int fq) const {
        const int col0 = u.pn * BM + wc * 32 + 4 * fq;
#pragma unroll
        for (int ai = 0; ai < 2; ++ai)
#pragma unroll
            for (int m = 0; m < 4; ++m) { const int row = u.pm * BM + ai * HALF + wr * 64 + m * 16 + fr; const size_t off = (size_t)row * 1024 + col0; float s = 0.f;
#pragma unroll
                for (int bj = 0; bj < 2; ++bj)
#pragma unroll
                    for (int n = 0; n < 2; ++n) { const f32x4 o = *(const f32x4*)(xin + off + bj * HALF + n * 16) + acc[ai][bj][m][n];
                        *(f32x4*)(xout + off + bj * HALF + n * 16) = o; s += (o[0] * o[0] + o[1] * o[1]) + (o[2] * o[2] + o[3] * o[3]);
                        if (write_xb) { u32x2 w; w.x = cvt_pk_bf16(o[0], o[1]); w.y = cvt_pk_bf16(o[2], o[3]); *(u32x2*)(xb + off + bj * HALF + n * 16) = w; } }
                s += __shfl_xor(s, 16); s += __shfl_xor(s, 32);
                if (fq == 0) atomicAdd(ssq + row, s);
                asm volatile("" ::: "memory"); }
    }
};
}

struct Frame {
    LAS unsigned char* lds;
    volatile LAS unsigned* MISC;
    gu32* ctl;
    int tid, lane, wave, vcu, G;
    unsigned char* ws;
};
struct Args { const float* in[14]; float* out; unsigned char* ws; int ph_lo, ph_hi; };
enum { I_X = 0, I_NORMW, I_WIN, I_CONVW, I_CONVB, I_DTB, I_ALOG, I_SSDD, I_SSDNW, I_GATEW, I_GATEB, I_GLANW, I_WOUT, I_FINW };
#define WSP(F, off) ((bf16*)((F).ws + (off)))
__device__ __forceinline__ const float* argp(const Args& a, int i) { asm volatile("" : "+s"(i)); return a.in[i]; }

__device__ __forceinline__ float wave_sum(float v) {
#pragma unroll
    for (int o = 1; o < 64; o <<= 1) v += __shfl_xor(v, o);
    return v;
}
__device__ __forceinline__ void cvt_win_item(const float* W, const float* nw, bf16* WT, LAS float* scr, int item, int lane) {
    const int nblk = PP / 32, kb = item / nblk, nb = item % nblk, k0 = 64 * kb, n0 = 32 * nb;
    const int n = n0 + (lane & 31); const bool valid = n < NPROJ; const int oc = valid ? proj_orig_col(n) : 0;
    const float cs = (n >= PC_SBQ && n < PC_SBQ + 512) ? 0.18033688011112042f : ((n >= PC_GQ && n < PC_GQ + 256) ? 0.125f : 1.f);
#pragma unroll 8
    for (int i = 0; i < 32; ++i) { const int kk = 2 * i + (lane >> 5); scr[kk * 33 + (lane & 31)] = valid ? W[(size_t)(k0 + kk) * NPROJ + oc] * nw[k0 + kk] * cs : 0.f; }
    LDS_WAIT(); asm volatile("" ::: "memory");
    const int c = lane & 7;
#pragma unroll
    for (int j = 0; j < 4; ++j) { const int nn = (lane >> 3) + 8 * j; const LAS float* s = scr + (8 * c) * 33 + nn;
        v4u o; o.x = pk2(s[0 * 33], s[1 * 33]); o.y = pk2(s[2 * 33], s[3 * 33]); o.z = pk2(s[4 * 33], s[5 * 33]); o.w = pk2(s[6 * 33], s[7 * 33]);
        *(GAS v4u*)(WT + (size_t)(n0 + nn) * DM + k0 + 8 * c) = o; }
    LDS_WAIT(); asm volatile("" ::: "memory");
}
__device__ __forceinline__ void cvt_wout_item(const float* W, const float* snw, bf16* WT, LAS float* scr, int item, int lane) {
    const int nblk = DM / 32, kb = item / nblk, nb = item % nblk, k0 = 64 * kb, n0 = 32 * nb;
#pragma unroll 8
    for (int i = 0; i < 32; ++i) { const int kk = k0 + 2 * i + (lane >> 5); const float sc = kk < 1024 ? snw[kk] : 1.f;
        scr[(2 * i + (lane >> 5)) * 33 + (lane & 31)] = W[(size_t)wout_src_row(kk) * DM + n0 + (lane & 31)] * sc; }
    LDS_WAIT(); asm volatile("" ::: "memory");
    const int c = lane & 7;
#pragma unroll
    for (int j = 0; j < 4; ++j) { const int nn = (lane >> 3) + 8 * j; const LAS float* s = scr + (8 * c) * 33 + nn;
        v4u o; o.x = pk2(s[0 * 33], s[1 * 33]); o.y = pk2(s[2 * 33], s[3 * 33]); o.z = pk2(s[4 * 33], s[5 * 33]); o.w = pk2(s[6 * 33], s[7 * 33]);
        *(GAS v4u*)(WT + (size_t)(n0 + nn) * DI + k0 + 8 * c) = o; }
    LDS_WAIT(); asm volatile("" ::: "memory");
}
constexpr int CVT_WIN_ITEMS = (DM / 64) * (PP / 32);
constexpr int CVT_WOUT_ITEMS = (DI / 64) * (DM / 32);
__device__ __forceinline__ void row_to_bf16(const float* xrow, bf16* orow, float* ssq, int lane) {
    const GAS f32x4* xr = (const GAS f32x4*)xrow + lane;
    f32x4 v[4]; float s = 0.f;
#pragma unroll
    for (int j = 0; j < 4; ++j) { v[j] = xr[64 * j]; s += (v[j].x * v[j].x + v[j].y * v[j].y) + (v[j].z * v[j].z + v[j].w * v[j].w); }
    s = wave_sum(s);
    GAS unsigned long long* o8 = (GAS unsigned long long*)orow + lane;
#pragma unroll
    for (int j = 0; j < 4; ++j) o8[64 * j] = (unsigned long long)pk2(v[j].x, v[j].y) | ((unsigned long long)pk2(v[j].z, v[j].w) << 32);
    if (lane == 0) *ssq = s;
}
namespace sba {
typedef short bf16x8 __attribute__((ext_vector_type(8)));
typedef short s16x4 __attribute__((ext_vector_type(4)));
typedef float f32x16 __attribute__((ext_vector_type(16)));
typedef float f32x2_t __attribute__((ext_vector_type(2)));
typedef __bf16 bf16x2_t __attribute__((ext_vector_type(2)));
__device__ __forceinline__ unsigned cvtpk(float lo, float hi) { f32x2_t v = {lo, hi}; bf16x2_t b = __builtin_convertvector(v, bf16x2_t); return __builtin_bit_cast(unsigned, b); }
__device__ __forceinline__ int crow(int r, int hi) { return (r & 3) + 8 * (r >> 2) + 4 * hi; }
constexpr int L_K = 0, L_V = 8192, L_BUF = 16384, L_FLG = 32768, L_STG = 33792;
constexpr float R_STOP = 8.67361738e-19f;

__device__ __forceinline__ void pv(f32x16* o, int vb, bf16x8 pa0, bf16x8 pa1, bf16x8 pa2, bf16x8 pa3) {
#pragma unroll
    for (int d0 = 0; d0 < 2; ++d0) { s16x4 lo[4], hi[4];
#pragma unroll
        for (int ks = 0; ks < 4; ++ks) {
            asm volatile("ds_read_b64_tr_b16 %0,%1 offset:%c2" : "=&v"(lo[ks]) : "v"(vb), "i"(d0 * 4096 + ks * 1024) : "memory");
            asm volatile("ds_read_b64_tr_b16 %0,%1 offset:%c2" : "=&v"(hi[ks]) : "v"(vb), "i"(d0 * 4096 + ks * 1024 + 512) : "memory"); }
        asm volatile("s_waitcnt lgkmcnt(0)" ::: "memory"); __builtin_amdgcn_sched_barrier(0);
#define SBA_PK(k) (bf16x8){lo[k][0], lo[k][1], lo[k][2], lo[k][3], hi[k][0], hi[k][1], hi[k][2], hi[k][3]}
        o[d0] = __builtin_amdgcn_mfma_f32_32x32x16_bf16(pa0, SBA_PK(0), o[d0], 0, 0, 0);
        o[d0] = __builtin_amdgcn_mfma_f32_32x32x16_bf16(pa1, SBA_PK(1), o[d0], 0, 0, 0);
        o[d0] = __builtin_amdgcn_mfma_f32_32x32x16_bf16(pa2, SBA_PK(2), o[d0], 0, 0, 0);
        o[d0] = __builtin_amdgcn_mfma_f32_32x32x16_bf16(pa3, SBA_PK(3), o[d0], 0, 0, 0);
#undef SBA_PK
    }
}

__device__ __forceinline__ void sb_item(Frame& F, int item) {
    int tid; { int t_ = threadIdx.x; asm volatile("" : "+v"(t_)); tid = t_; }
    const int lane = tid & 63, r32 = lane & 31, hi = lane >> 5; const int wid = __builtin_amdgcn_readfirstlane(tid >> 6);
    const int b = item >> 6, h = (item >> 3) & 7, qb = 7 - (item & 7), q0 = qb * 256;
    bf16* P = WSP(F, WS_PROJ) + (size_t)b * SEQ * PP;
    LAS unsigned char* lds = F.lds;
    volatile LAS unsigned* flg = (volatile LAS unsigned*)(lds + L_FLG);
    bf16x8 qr[4];
    { const bf16* Qw = P + (size_t)(q0 + 32 * wid + r32) * PP + PC_SBQ + h * 64;
#pragma unroll
      for (int d0 = 0; d0 < 4; ++d0) qr[d0] = *(const bf16x8*)(Qw + d0 * 16 + hi * 8); }
    const bf16* ksrc = P + (size_t)lane * PP + PC_SBK + h * 64 + wid * 8;
    const bf16* vsrc = P + (size_t)(16 * (wid & 3) + (lane >> 2)) * PP + PC_SBV + h * 64 + (wid >> 2) * 32 + (lane & 3) * 8;
    const int sdst = wid * 1024 + lane * 16;
    const int vb0 = (int)(unsigned)(size_t)(lds + L_V) + ((lane >> 4) & 1) * 32 + (lane & 3) * 8 + (4 * hi + ((lane & 15) >> 2)) * 64;
    const int kb0 = hi * 1024 + r32 * 16;
    int kt = (q0 + 256) / 64 - 1;
    v4u kreg = *(const v4u*)(ksrc + (size_t)kt * 64 * PP), vreg = *(const v4u*)(vsrc + (size_t)kt * 64 * PP);
    __syncthreads();
    *(LAS v4u*)(lds + L_K + sdst) = kreg; *(LAS v4u*)(lds + L_V + sdst) = vreg;
    __syncthreads();
    float R = 1.f; f32x16 o[2]; o[0] = f32x16{}; o[1] = f32x16{};
    const int tq = q0 + 32 * wid + r32, wmin = q0 + 32 * wid, wmax = wmin + 31;
    bool wdone = false; int buf = 0;
    for (;;) {
        const bool has_next = kt > 0;
        if (has_next) { kreg = *(const v4u*)(ksrc + (size_t)(kt - 1) * 64 * PP); vreg = *(const v4u*)(vsrc + (size_t)(kt - 1) * 64 * PP); }
        if (!wdone && 64 * kt < wmax) {
            const LAS unsigned char* Kb = lds + buf * L_BUF + L_K + kb0;
            f32x16 p0, p1;
#pragma unroll
            for (int d0 = 0; d0 < 4; ++d0) {
                const bf16x8 a0 = *(const LAS bf16x8*)(Kb + d0 * 2048), a1 = *(const LAS bf16x8*)(Kb + d0 * 2048 + 512);
                if (d0 == 0) { p0 = __builtin_amdgcn_mfma_f32_32x32x16_bf16(a0, qr[0], f32x16{}, 0, 0, 0); p1 = __builtin_amdgcn_mfma_f32_32x32x16_bf16(a1, qr[0], f32x16{}, 0, 0, 0); }
                else { p0 = __builtin_amdgcn_mfma_f32_32x32x16_bf16(a0, qr[d0], p0, 0, 0, 0); p1 = __builtin_amdgcn_mfma_f32_32x32x16_bf16(a1, qr[d0], p1, 0, 0, 0); } }
            f32x16 m0, m1;
            const bool need_mask = (64 * kt + 63 >= wmin);
#pragma unroll
            for (int r = 0; r < 16; ++r) {
                { const float e = __builtin_amdgcn_exp2f(fminf(p0[r], 100.f)); float om = __builtin_amdgcn_rcpf(1.f + e); float be = e * om;
                  if (need_mask && (64 * kt + crow(r, hi) >= tq)) { om = 1.f; be = 0.f; } m0[r] = om; p0[r] = be; }
                { const float e = __builtin_amdgcn_exp2f(fminf(p1[r], 100.f)); float om = __builtin_amdgcn_rcpf(1.f + e); float be = e * om;
                  if (need_mask && (64 * kt + 32 + crow(r, hi) >= tq)) { om = 1.f; be = 0.f; } m1[r] = om; p1[r] = be; }
            }
            float totE[8], totO[8];
#pragma unroll
            for (int g = 0; g < 4; ++g) {
                { const float t3 = m0[4 * g + 3], t2 = m0[4 * g + 2], t1 = m0[4 * g + 1], t0 = m0[4 * g]; const float s1 = t3 * t2, s0 = s1 * t1, tot = s0 * t0;
                  m0[4 * g + 2] = t3; m0[4 * g + 1] = s1; m0[4 * g] = s0;
                  auto rr = __builtin_amdgcn_permlane32_swap(__float_as_uint(tot), __float_as_uint(tot), false, false); totE[g] = __uint_as_float(rr[0]); totO[g] = __uint_as_float(rr[1]); }
                { const float t3 = m1[4 * g + 3], t2 = m1[4 * g + 2], t1 = m1[4 * g + 1], t0 = m1[4 * g]; const float s1 = t3 * t2, s0 = s1 * t1, tot = s0 * t0;
                  m1[4 * g + 2] = t3; m1[4 * g + 1] = s1; m1[4 * g] = s0;
                  auto rr = __builtin_amdgcn_permlane32_swap(__float_as_uint(tot), __float_as_uint(tot), false, false); totE[4 + g] = __uint_as_float(rr[0]); totO[4 + g] = __uint_as_float(rr[1]); }
            }
            float pref = R;
#pragma unroll
            for (int g = 7; g >= 0; --g) {
                const float sufO = pref; pref *= totO[g]; const float sufE = pref; pref *= totE[g];
                const float suf = hi ? sufO : sufE;
                if (g >= 4) { const int gg = g - 4; p1[4 * gg + 3] *= suf; p1[4 * gg + 2] *= m1[4 * gg + 2] * suf; p1[4 * gg + 1] *= m1[4 * gg + 1] * suf; p1[4 * gg] *= m1[4 * gg] * suf; }
                else { p0[4 * g + 3] *= suf; p0[4 * g + 2] *= m0[4 * g + 2] * suf; p0[4 * g + 1] *= m0[4 * g + 1] * suf; p0[4 * g] *= m0[4 * g] * suf; }
            }
            R = pref;
            v4u pw0, pw1, pw2, pw3;
            pw0 = (v4u){cvtpk(p0[0], p0[1]), cvtpk(p0[2], p0[3]), cvtpk(p0[4], p0[5]), cvtpk(p0[6], p0[7])};
            pw1 = (v4u){cvtpk(p0[8], p0[9]), cvtpk(p0[10], p0[11]), cvtpk(p0[12], p0[13]), cvtpk(p0[14], p0[15])};
            pw2 = (v4u){cvtpk(p1[0], p1[1]), cvtpk(p1[2], p1[3]), cvtpk(p1[4], p1[5]), cvtpk(p1[6], p1[7])};
            pw3 = (v4u){cvtpk(p1[8], p1[9]), cvtpk(p1[10], p1[11]), cvtpk(p1[12], p1[13]), cvtpk(p1[14], p1[15])};
            __builtin_amdgcn_sched_barrier(0);
            pv(o, vb0 + buf * L_BUF, __builtin_bit_cast(bf16x8, pw0), __builtin_bit_cast(bf16x8, pw1), __builtin_bit_cast(bf16x8, pw2), __builtin_bit_cast(bf16x8, pw3));
            wdone = __all(R < R_STOP);
        }
        if (lane == 0) flg[(kt & 1) * 8 + wid] = wdone ? 1u : 0u;
        if (has_next) { *(LAS v4u*)(lds + (buf ^ 1) * L_BUF + L_K + sdst) = kreg; *(LAS v4u*)(lds + (buf ^ 1) * L_BUF + L_V + sdst) = vreg; }
        __syncthreads();
        unsigned alld = 1u;
#pragma unroll
        for (int w = 0; w < 8; ++w) alld &= flg[(kt & 1) * 8 + w];
        if (alld || !has_next) break;
        --kt; buf ^= 1;
    }
    LAS float* stg = (LAS float*)(lds + L_STG + wid * 8704);
#pragma unroll
    for (int r = 0; r < 16; ++r) { const int orow = crow(r, hi); stg[orow * 68 + r32] = o[0][r]; stg[orow * 68 + 32 + r32] = o[1][r]; }
    asm volatile("s_waitcnt lgkmcnt(0)" ::: "memory");
    bf16* Zw = P + (size_t)(q0 + 32 * wid) * PP + PC_SBZ + h * 64;
#pragma unroll
    for (int i = 0; i < 4; ++i) { const int row = i * 8 + (lane >> 3), ch = lane & 7;
        const f32x4 a = *(const LAS f32x4*)(stg + row * 68 + ch * 8), c = *(const LAS f32x4*)(stg + row * 68 + ch * 8 + 4);
        v4u* zp = (v4u*)(Zw + (size_t)row * PP + ch * 8); const v4u z = *zp; v4u y;
        y.x = pk2(a[0] * siluf(bflo(z.x)), a[1] * siluf(bfhi(z.x))); y.y = pk2(a[2] * siluf(bflo(z.y)), a[3] * siluf(bfhi(z.y)));
        y.z = pk2(c[0] * siluf(bflo(z.z)), c[1] * siluf(bfhi(z.z))); y.w = pk2(c[2] * siluf(bflo(z.w)), c[3] * siluf(bfhi(z.w)));
        *zp = y; }
}
}
namespace ssd {
typedef short bf16x8 __attribute__((ext_vector_type(8)));
typedef short s16x4 __attribute__((ext_vector_type(4)));
typedef float f32x16 __attribute__((ext_vector_type(16)));
typedef float f32x2_t __attribute__((ext_vector_type(2)));
typedef __bf16 bf16x2_t __attribute__((ext_vector_type(2)));
__device__ __forceinline__ unsigned cvtpk(float lo, float hi) { f32x2_t v = {lo, hi}; bf16x2_t b = __builtin_convertvector(v, bf16x2_t); return __builtin_bit_cast(unsigned, b); }
__device__ __forceinline__ int crow(int r, int hi) { return (r & 3) + 8 * (r >> 2) + 4 * hi; }
constexpr int PC_ = 272  , PT_ = 144  , PY_ = 272  ;
constexpr int O_CRM = 0, O_BRM = O_CRM + 64 * PC_, O_BTT = O_BRM + 64 * PC_, O_XST = O_BTT + 128 * PT_, O_XT = O_XST + 64 * PT_, O_HBF = O_XT + 64 * PT_,
              O_YB = O_HBF + 64 * PC_, O_L = O_YB + 64 * PY_  , O_SC = O_L + 64 * PT_  , O_CW = O_SC + 1024  , O_END = O_CW + 5 * 320 * 4;
static_assert(O_END <= 131072, "ssd lds");

__device__ __forceinline__ void conv8(const v4u (&raw)[4], const LAS float* cwp, float (&out)[8]) {
    const f32x4 b0 = *(const LAS f32x4*)(cwp + 4 * 320), b1 = *(const LAS f32x4*)(cwp + 4 * 320 + 4);
    float acc[8] = {b0[0], b0[1], b0[2], b0[3], b1[0], b1[1], b1[2], b1[3]};
#pragma unroll
    for (int k = 0; k < 4; ++k) { const f32x4 w0 = *(const LAS f32x4*)(cwp + k * 320), w1 = *(const LAS f32x4*)(cwp + k * 320 + 4); const v4u r = raw[k];
        acc[0] += w0[0] * bflo(r.x); acc[1] += w0[1] * bfhi(r.x); acc[2] += w0[2] * bflo(r.y); acc[3] += w0[3] * bfhi(r.y);
        acc[4] += w1[0] * bflo(r.z); acc[5] += w1[1] * bfhi(r.z); acc[6] += w1[2] * bflo(r.w); acc[7] += w1[3] * bfhi(r.w); }
#pragma unroll
    for (int i = 0; i < 8; ++i) out[i] = acc[i] * __builtin_amdgcn_rcpf(1.f + __builtin_amdgcn_exp2f(-1.4426950408889634f * acc[i]));
}

__device__ __forceinline__ void ssd_item(Frame& F, const Args& args, int item, int layer) {
    int tid; { int t_ = threadIdx.x; asm volatile("" : "+v"(t_)); tid = t_; }
    const int lane = tid & 63, r32 = lane & 31, hi = lane >> 5; const int wid = __builtin_amdgcn_readfirstlane(tid >> 6);
    const int b = item >> 4, head = item & 15, g = head >> 3;
    bf16* P = WSP(F, WS_PROJ) + (size_t)b * SEQ * PP;
    float* ssqg = (float*)(F.ctl + CW_SSQG) + ((size_t)layer * T + (size_t)b * SEQ) * 2 + g;
    LAS unsigned char* lds = F.lds;
    LAS float* sc = (LAS float*)(lds + O_SC);
    LAS float* cwl = (LAS float*)(lds + O_CW);
    const float A = -expf(argp(args, I_ALOG)[layer * 16 + head]), Dk = argp(args, I_SSDD)[layer * 16 + head], dtb = argp(args, I_DTB)[layer * 16 + head];
    __syncthreads();
    { const float* cw = argp(args, I_CONVW) + layer * 4 * 1536; const float* cb = argp(args, I_CONVB) + layer * 1536;
      for (int e = tid; e < 5 * 320; e += 512) { const int k = e / 320, c = e % 320; const int ch = c < 64 ? head * 64 + c : (c < 192 ? 1024 + g * 128 + (c - 64) : 1280 + g * 128 + (c - 192));
          cwl[e] = k < 4 ? cw[k * 1536 + ch] : cb[ch]; }
      for (int e = tid; e < (64 * PC_ + 64 * PY_ + 64 * PT_) / 4; e += 512) ((LAS unsigned*)(lds + O_HBF))[e] = 0u; }
    const int xtok = tid >> 3, xcg = tid & 7;
    const bf16* xsrc = P + (size_t)xtok * PP + PC_XBC + head * 64 + xcg * 8;
    bf16* zsrc = P + (size_t)xtok * PP + PC_SSDZ + head * 64 + xcg * 8;
    const bf16* dsrc = P + (size_t)lane * PP + PC_DT + head;
    const int bctok0 = tid >> 5, bccg = tid & 31;
    const bf16* bcsrc = P + (size_t)bctok0 * PP + PC_XBC + 1024 + (bccg >> 4) * 256 + g * 128 + (bccg & 15) * 8;
    v4u xr[4], bcr[4][4], zr; unsigned short dtr;
#define SSD_LOAD(c) do { const size_t ro = (size_t)(c) * 64 * PP; \
        _Pragma("unroll") for (int k = 0; k < 4; ++k) { const bool ok = ((c) > 0) || (xtok - 3 + k >= 0); xr[k] = ok ? *(const v4u*)(xsrc + ro + (ptrdiff_t)(k - 3) * PP) : (v4u){0u, 0u, 0u, 0u}; } \
        _Pragma("unroll") for (int j = 0; j < 4; ++j) _Pragma("unroll") for (int k = 0; k < 4; ++k) { const int tk = bctok0 + 16 * j; const bool ok = ((c) > 0) || (tk - 3 + k >= 0); \
            bcr[j][k] = ok ? *(const v4u*)(bcsrc + ro + (ptrdiff_t)(16 * j + k - 3) * PP) : (v4u){0u, 0u, 0u, 0u}; } \
        zr = *(const v4u*)(zsrc + ro); dtr = dsrc[ro]; } while (0)
    SSD_LOAD(0);
    f32x16 hacc = f32x16{};
    const int nt_ = wid >> 1, pt_ = wid & 1;
    __syncthreads();
    unsigned pacc0 = 0, pacc1 = 0, pacc2 = 0;
#pragma unroll 1
    for (int c = 0; c < 32; ++c) {
        const unsigned pt0 = MK_PROBE ? (unsigned)__builtin_amdgcn_s_memrealtime() : 0u;
        float dtv, acs, wv, dc;
        { dtv = softplusf(bf2f(dtr) + dtb); const float a = A * dtv; float s = a;
#pragma unroll
          for (int o = 1; o < 64; o <<= 1) { const float u = __shfl_up(s, o); if (lane >= o) s += u; }
          acs = s; const float tot = __shfl(s, 63); wv = __expf(tot - acs) * dtv; dc = __expf(tot);
          if (wid == 0) { sc[lane] = acs; sc[64 + lane] = dtv; sc[128 + lane] = __expf(acs); } }
        float xv[8];
        { conv8(xr, cwl + xcg * 8, xv); const float wt = __shfl(wv, xtok);
#pragma unroll
          for (int i = 0; i < 8; ++i) { const int p = xcg * 8 + i; *(LAS bf16*)(lds + O_XT + p * PT_ + xtok * 2) = (bf16)f2bf(xv[i]); *(LAS bf16*)(lds + O_XST + p * PT_ + xtok * 2) = (bf16)f2bf(xv[i] * wt); } }
#pragma unroll
        for (int j = 0; j < 4; ++j) { float v[8]; const int tok = bctok0 + 16 * j; const int n0 = (bccg & 15) * 8;
            conv8(bcr[j], cwl + 64 + (bccg >> 4) * 128 + n0, v);
            v4u pk; pk.x = cvtpk(v[0], v[1]); pk.y = cvtpk(v[2], v[3]); pk.z = cvtpk(v[4], v[5]); pk.w = cvtpk(v[6], v[7]);
            if (bccg < 16) { *(LAS v4u*)(lds + O_BRM + tok * PC_ + n0 * 2) = pk;
#pragma unroll
                for (int i = 0; i < 8; ++i) *(LAS bf16*)(lds + O_BTT + (n0 + i) * PT_ + tok * 2) = (bf16)f2bf(v[i]); }
            else *(LAS v4u*)(lds + O_CRM + tok * PC_ + n0 * 2) = pk; }
        const v4u zcur = zr;
        __syncthreads();
        const unsigned pt1 = MK_PROBE ? (unsigned)__builtin_amdgcn_s_memrealtime() : 0u;
        if (c + 1 < 32) SSD_LOAD(c + 1);
        if (wid < 3) {
            const int mt = wid >> 1, lt = (wid + 1) >> 1;
            f32x16 gacc = f32x16{};
#pragma unroll
            for (int s = 0; s < 8; ++s) { const bf16x8 a = *(const LAS bf16x8*)(lds + O_BRM + (32 * mt + r32) * PC_ + (16 * s + 8 * hi) * 2), bb = *(const LAS bf16x8*)(lds + O_CRM + (32 * lt + r32) * PC_ + (16 * s + 8 * hi) * 2);
                gacc = __builtin_amdgcn_mfma_f32_32x32x16_bf16(a, bb, gacc, 0, 0, 0); }
            const float acs_l = sc[32 * lt + r32]; const int lcol = 32 * lt + r32;
#pragma unroll
            for (int gq = 0; gq < 4; ++gq) { const int mb = 32 * mt + 8 * gq + 4 * hi; const f32x4 am = *(const LAS f32x4*)(sc + mb), dm = *(const LAS f32x4*)(sc + 64 + mb); float v[4];
#pragma unroll
                for (int i = 0; i < 4; ++i) { const float t = gacc[4 * gq + i] * __expf(fminf(acs_l - am[i], 0.f)) * dm[i]; v[i] = (mb + i <= lcol) ? t : 0.f; }
                *(LAS v2u*)(lds + O_L + lcol * PT_ + mb * 2) = (v2u){cvtpk(v[0], v[1]), cvtpk(v[2], v[3])}; }
        }
        hacc = hacc * dc;
#pragma unroll
        for (int s = 0; s < 4; ++s) { const bf16x8 a = *(const LAS bf16x8*)(lds + O_BTT + (32 * nt_ + r32) * PT_ + (16 * s + 8 * hi) * 2), bb = *(const LAS bf16x8*)(lds + O_XST + (32 * pt_ + r32) * PT_ + (16 * s + 8 * hi) * 2);
            hacc = __builtin_amdgcn_mfma_f32_32x32x16_bf16(a, bb, hacc, 0, 0, 0); }
        __syncthreads();
        if (wid < 4) {
            const int lt = wid >> 1, pt = wid & 1;
            f32x16 yd = f32x16{}, yo = f32x16{};
#pragma unroll
            for (int s = 0; s < 4; ++s) if (s < 2 || lt) { const bf16x8 a = *(const LAS bf16x8*)(lds + O_L + (32 * lt + r32) * PT_ + (16 * s + 8 * hi) * 2), bb = *(const LAS bf16x8*)(lds + O_XT + (32 * pt + r32) * PT_ + (16 * s + 8 * hi) * 2);
                yd = __builtin_amdgcn_mfma_f32_32x32x16_bf16(a, bb, yd, 0, 0, 0); }
#pragma unroll
            for (int s = 0; s < 8; ++s) { const bf16x8 a = *(const LAS bf16x8*)(lds + O_CRM + (32 * lt + r32) * PC_ + (16 * s + 8 * hi) * 2), bb = *(const LAS bf16x8*)(lds + O_HBF + (32 * pt + r32) * PC_ + (16 * s + 8 * hi) * 2);
                yo = __builtin_amdgcn_mfma_f32_32x32x16_bf16(a, bb, yo, 0, 0, 0); }
#pragma unroll
            for (int gq = 0; gq < 4; ++gq) { const int lb = 32 * lt + 8 * gq + 4 * hi; const f32x4 el = *(const LAS f32x4*)(sc + 128 + lb);
#pragma unroll
                for (int i = 0; i < 4; ++i) *((LAS float*)(lds + O_YB + (lb + i) * PY_) + 32 * pt + r32) = yd[4 * gq + i] + yo[4 * gq + i] * el[i]; }
        }
        __syncthreads();
        const unsigned pt2 = MK_PROBE ? (unsigned)__builtin_amdgcn_s_memrealtime() : 0u;
        { LAS float* yb = (LAS float*)(lds + O_YB + xtok * PY_) + xcg * 8; const f32x4 y0 = *(const LAS f32x4*)yb, y1 = *(const LAS f32x4*)(yb + 4);
          float yg[8];
          yg[0] = (y0[0] + Dk * xv[0]) * siluf(bflo(zcur.x)); yg[1] = (y0[1] + Dk * xv[1]) * siluf(bfhi(zcur.x)); yg[2] = (y0[2] + Dk * xv[2]) * siluf(bflo(zcur.y)); yg[3] = (y0[3] + Dk * xv[3]) * siluf(bfhi(zcur.y));
          yg[4] = (y1[0] + Dk * xv[4]) * siluf(bflo(zcur.z)); yg[5] = (y1[1] + Dk * xv[5]) * siluf(bfhi(zcur.z)); yg[6] = (y1[2] + Dk * xv[6]) * siluf(bflo(zcur.w)); yg[7] = (y1[3] + Dk * xv[7]) * siluf(bfhi(zcur.w));
          float s = 0.f;
#pragma unroll
          for (int i = 0; i < 8; ++i) s += yg[i] * yg[i];
          s += __shfl_xor(s, 1); s += __shfl_xor(s, 2); s += __shfl_xor(s, 4);
          if (xcg == 0) atomicAdd(ssqg + (size_t)(c * 64 + xtok) * 2, s);
          v4u o; o.x = cvtpk(yg[0], yg[1]); o.y = cvtpk(yg[2], yg[3]); o.z = cvtpk(yg[4], yg[5]); o.w = cvtpk(yg[6], yg[7]);
          *(v4u*)(zsrc + (size_t)c * 64 * PP) = o; }
#pragma unroll
        for (int gq = 0; gq < 4; ++gq) { v2u w; w.x = cvtpk(hacc[4 * gq], hacc[4 * gq + 1]); w.y = cvtpk(hacc[4 * gq + 2], hacc[4 * gq + 3]);
            *(LAS v2u*)(lds + O_HBF + (32 * pt_ + r32) * PC_ + (32 * nt_ + 8 * gq + 4 * hi) * 2) = w; }
        __syncthreads();
        if (MK_PROBE) { const unsigned pt3 = (unsigned)__builtin_amdgcn_s_memrealtime(); pacc0 += pt1 - pt0; pacc1 += pt2 - pt1; pacc2 += pt3 - pt2; }
    }
    if (MK_PROBE && item == 0 && layer == 0 && tid == 0) { unsigned* ts = (unsigned*)(F.ctl + CW_TS); ts[48] = pacc0; ts[49] = pacc1; ts[50] = pacc2; ts[51] = 0u; }
#undef SSD_LOAD
}
}
namespace gla {
typedef short bf16x8 __attribute__((ext_vector_type(8)));
typedef float f32x16 __attribute__((ext_vector_type(16)));
typedef float f32x2_t __attribute__((ext_vector_type(2)));
typedef __bf16 bf16x2_t __attribute__((ext_vector_type(2)));
__device__ __forceinline__ unsigned cvtpk(float lo, float hi) { f32x2_t v = {lo, hi}; bf16x2_t b = __builtin_convertvector(v, bf16x2_t); return __builtin_bit_cast(unsigned, b); }
__device__ __forceinline__ int crow(int r, int hi) { return (r & 3) + 8 * (r >> 2) + 4 * hi; }
constexpr int PT_ = 144;
constexpr int PO_ = 528;
constexpr int O_QT = 0, O_KRM = O_QT + 64 * PT_, O_KTT = O_KRM + 64 * PT_, O_VT = O_KTT + 64 * PT_, O_ST = O_VT + 128 * PT_, O_OB = O_ST + 128 * PT_, O_AT = O_OB + 64 * PO_  ,
              O_EG = O_AT + 64 * PT_  , O_GW = O_EG + 256  , O_GB = O_GW + 4096  , O_NW = O_GB + 256  , O_END = O_NW + 512;
static_assert(O_END <= 131072, "gla lds");

__device__ __forceinline__ void gla_item(Frame& F, const Args& args, int item, int layer) {
    int tid; { int t_ = threadIdx.x; asm volatile("" : "+v"(t_)); tid = t_; }
    const int lane = tid & 63, r32 = lane & 31, hi = lane >> 5; const int wid = __builtin_amdgcn_readfirstlane(tid >> 6);
    const int b = item >> 2, h = item & 3;
    bf16* P = WSP(F, WS_PROJ) + (size_t)b * SEQ * PP;
    LAS unsigned char* lds = F.lds;
    LAS float* egl = (LAS float*)(lds + O_EG); LAS float* gwl = (LAS float*)(lds + O_GW); LAS float* gbl = (LAS float*)(lds + O_GB); LAS float* nwl = (LAS float*)(lds + O_NW);
    __syncthreads();
    { const float* gw = argp(args, I_GATEW) + layer * 16 * 256; const float* gb = argp(args, I_GATEB) + layer * 256; const float* nw = argp(args, I_GLANW) + layer * 128;
      for (int e = tid; e < 1024; e += 512) gwl[e] = gw[(e >> 6) * 256 + h * 64 + (e & 63)];
      if (tid < 64) gbl[tid] = gb[h * 64 + tid];
      if (tid < 128) nwl[tid] = nw[tid];
      for (int e = tid; e < (128 * PT_ + 64 * PO_ + 64 * PT_) / 4; e += 512) ((LAS unsigned*)(lds + O_ST))[e] = 0u; }
    const int kd0 = 8 * wid;
    const bf16* qsrc = P + (size_t)lane * PP + PC_GQ + h * 64 + kd0;
    const bf16* ksrc = P + (size_t)lane * PP + PC_GK + h * 64 + kd0;
    const bf16* gsrc = P + (size_t)lane * PP + PC_GLR;
    const int vtok0 = tid >> 4, vg = tid & 15;
    const bf16* vsrc = P + (size_t)vtok0 * PP + PC_GV + h * 128 + vg * 8;
    const int otok = tid >> 3, og = tid & 7;
    bf16* zsrc = P + (size_t)otok * PP + PC_GZ + h * 128 + og * 16;
    v4u qr, kr, gr0, gr1, vr[2], zr0, zr1;
#define GLA_LOAD(c) do { const size_t ro = (size_t)(c) * 64 * PP; qr = *(const v4u*)(qsrc + ro); kr = *(const v4u*)(ksrc + ro); gr0 = *(const v4u*)(gsrc + ro); gr1 = *(const v4u*)(gsrc + ro + 8); \
        vr[0] = *(const v4u*)(vsrc + ro); vr[1] = *(const v4u*)(vsrc + ro + (size_t)32 * PP); zr0 = *(const v4u*)(zsrc + ro); zr1 = *(const v4u*)(zsrc + ro + 8); } while (0)
    GLA_LOAD(0);
    f32x16 sacc = f32x16{};
    const int kt_ = wid >> 2, vt_ = wid & 3;
    __syncthreads();
    unsigned pacc0 = 0, pacc1 = 0, pacc2 = 0;
#pragma unroll 1
    for (int c = 0; c < 32; ++c) {
        const unsigned pt0 = MK_PROBE ? (unsigned)__builtin_amdgcn_s_memrealtime() : 0u;
        { float glr[16];
          glr[0] = bflo(gr0.x); glr[1] = bfhi(gr0.x); glr[2] = bflo(gr0.y); glr[3] = bfhi(gr0.y); glr[4] = bflo(gr0.z); glr[5] = bfhi(gr0.z); glr[6] = bflo(gr0.w); glr[7] = bfhi(gr0.w);
          glr[8] = bflo(gr1.x); glr[9] = bfhi(gr1.x); glr[10] = bflo(gr1.y); glr[11] = bfhi(gr1.y); glr[12] = bflo(gr1.z); glr[13] = bfhi(gr1.z); glr[14] = bflo(gr1.w); glr[15] = bfhi(gr1.w);
          float G[8];
          { const f32x4 b0 = *(const LAS f32x4*)(gbl + kd0), b1 = *(const LAS f32x4*)(gbl + kd0 + 4); G[0] = b0[0]; G[1] = b0[1]; G[2] = b0[2]; G[3] = b0[3]; G[4] = b1[0]; G[5] = b1[1]; G[6] = b1[2]; G[7] = b1[3]; }
#pragma unroll
          for (int r = 0; r < 16; ++r) { const f32x4 w0 = *(const LAS f32x4*)(gwl + r * 64 + kd0), w1 = *(const LAS f32x4*)(gwl + r * 64 + kd0 + 4);
              G[0] += glr[r] * w0[0]; G[1] += glr[r] * w0[1]; G[2] += glr[r] * w0[2]; G[3] += glr[r] * w0[3]; G[4] += glr[r] * w1[0]; G[5] += glr[r] * w1[1]; G[6] += glr[r] * w1[2]; G[7] += glr[r] * w1[3]; }
#pragma unroll
          for (int i = 0; i < 8; ++i) { const float x = G[i]; float s = (fminf(x, 0.f) - __logf(1.f + __expf(-fabsf(x)))) * (1.f / 16.f);
#pragma unroll
              for (int o = 1; o < 64; o <<= 1) { const float u = __shfl_up(s, o); if (lane >= o) s += u; }
              G[i] = s; }
          const float qf[8] = {bflo(qr.x), bfhi(qr.x), bflo(qr.y), bfhi(qr.y), bflo(qr.z), bfhi(qr.z), bflo(qr.w), bfhi(qr.w)};
          const float kf[8] = {bflo(kr.x), bfhi(kr.x), bflo(kr.y), bfhi(kr.y), bflo(kr.z), bfhi(kr.z), bflo(kr.w), bfhi(kr.w)};
          float qt[8], kt[8];
#pragma unroll
          for (int i = 0; i < 8; ++i) { const float eg = __expf(G[i]); qt[i] = qf[i] * eg; kt[i] = kf[i] * __expf(fminf(-G[i], 80.f)); if (lane == 63) egl[kd0 + i] = eg; }
          *(LAS v4u*)(lds + O_QT + lane * PT_ + kd0 * 2) = (v4u){cvtpk(qt[0], qt[1]), cvtpk(qt[2], qt[3]), cvtpk(qt[4], qt[5]), cvtpk(qt[6], qt[7])};
          *(LAS v4u*)(lds + O_KRM + lane * PT_ + kd0 * 2) = (v4u){cvtpk(kt[0], kt[1]), cvtpk(kt[2], kt[3]), cvtpk(kt[4], kt[5]), cvtpk(kt[6], kt[7])};
#pragma unroll
          for (int i = 0; i < 8; ++i) *(LAS bf16*)(lds + O_KTT + (kd0 + i) * PT_ + lane * 2) = (bf16)f2bf(kt[i]); }
#pragma unroll
        for (int j = 0; j < 2; ++j) { const int tok = vtok0 + 32 * j; const v4u w = vr[j];
            const unsigned ww[4] = {w.x, w.y, w.z, w.w};
#pragma unroll
            for (int i = 0; i < 8; ++i) *(LAS bf16*)(lds + O_VT + (vg * 8 + i) * PT_ + tok * 2) = (bf16)((i & 1) ? (ww[i >> 1] >> 16) : (ww[i >> 1] & 0xffffu)); }
        const v4u zc0 = zr0, zc1 = zr1;
        __syncthreads();
        const unsigned pt1 = MK_PROBE ? (unsigned)__builtin_amdgcn_s_memrealtime() : 0u;
        if (c + 1 < 32) GLA_LOAD(c + 1);
        if (wid < 3) {
            const int st = wid >> 1, tt = (wid + 1) >> 1;
            f32x16 at = f32x16{};
#pragma unroll
            for (int s = 0; s < 4; ++s) { const bf16x8 a = *(const LAS bf16x8*)(lds + O_KRM + (32 * st + r32) * PT_ + (16 * s + 8 * hi) * 2), bb = *(const LAS bf16x8*)(lds + O_QT + (32 * tt + r32) * PT_ + (16 * s + 8 * hi) * 2);
                at = __builtin_amdgcn_mfma_f32_32x32x16_bf16(a, bb, at, 0, 0, 0); }
            if (st == tt) {
#pragma unroll
                for (int r = 0; r < 16; ++r) if (crow(r, hi) > r32) at[r] = 0.f; }
#pragma unroll
            for (int gq = 0; gq < 4; ++gq) *(LAS v2u*)(lds + O_AT + (32 * tt + r32) * PT_ + (32 * st + 8 * gq + 4 * hi) * 2) = (v2u){cvtpk(at[4 * gq], at[4 * gq + 1]), cvtpk(at[4 * gq + 2], at[4 * gq + 3])};
        }
        {
#pragma unroll
            for (int s = 0; s < 4; ++s) { const bf16x8 a = *(const LAS bf16x8*)(lds + O_KTT + (32 * kt_ + r32) * PT_ + (16 * s + 8 * hi) * 2), bb = *(const LAS bf16x8*)(lds + O_VT + (32 * vt_ + r32) * PT_ + (16 * s + 8 * hi) * 2);
                sacc = __builtin_amdgcn_mfma_f32_32x32x16_bf16(a, bb, sacc, 0, 0, 0); }
#pragma unroll
            for (int gq = 0; gq < 4; ++gq) { const f32x4 e = *(const LAS f32x4*)(egl + 32 * kt_ + 8 * gq + 4 * hi);
                sacc[4 * gq] *= e[0]; sacc[4 * gq + 1] *= e[1]; sacc[4 * gq + 2] *= e[2]; sacc[4 * gq + 3] *= e[3]; }
        }
        __syncthreads();
        {
            f32x16 oi = f32x16{};
#pragma unroll
            for (int s = 0; s < 4; ++s) { const bf16x8 a = *(const LAS bf16x8*)(lds + O_QT + (32 * kt_ + r32) * PT_ + (16 * s + 8 * hi) * 2), bb = *(const LAS bf16x8*)(lds + O_ST + (32 * vt_ + r32) * PT_ + (16 * s + 8 * hi) * 2);
                oi = __builtin_amdgcn_mfma_f32_32x32x16_bf16(a, bb, oi, 0, 0, 0); }
#pragma unroll
            for (int s = 0; s < 4; ++s) if (s < 2 || kt_) { const bf16x8 a = *(const LAS bf16x8*)(lds + O_AT + (32 * kt_ + r32) * PT_ + (16 * s + 8 * hi) * 2), bb = *(const LAS bf16x8*)(lds + O_VT + (32 * vt_ + r32) * PT_ + (16 * s + 8 * hi) * 2);
                oi = __builtin_amdgcn_mfma_f32_32x32x16_bf16(a, bb, oi, 0, 0, 0); }
#pragma unroll
            for (int r = 0; r < 16; ++r) *((LAS float*)(lds + O_OB + (32 * kt_ + crow(r, hi)) * PO_) + 32 * vt_ + r32) = oi[r];
        }
        __syncthreads();
        const unsigned pt2 = MK_PROBE ? (unsigned)__builtin_amdgcn_s_memrealtime() : 0u;
        { LAS float* ob = (LAS float*)(lds + O_OB + otok * PO_) + og * 16; float o[16];
#pragma unroll
          for (int q4 = 0; q4 < 4; ++q4) { const f32x4 t4 = *(const LAS f32x4*)(ob + 4 * q4); o[4 * q4] = t4[0]; o[4 * q4 + 1] = t4[1]; o[4 * q4 + 2] = t4[2]; o[4 * q4 + 3] = t4[3]; }
          float s = 0.f;
#pragma unroll
          for (int i = 0; i < 16; ++i) s += o[i] * o[i];
          s += __shfl_xor(s, 1); s += __shfl_xor(s, 2); s += __shfl_xor(s, 4);
          const float rs = rsqrtf(s * (1.f / 128.f) + EPS);
          const unsigned zw[8] = {zc0.x, zc0.y, zc0.z, zc0.w, zc1.x, zc1.y, zc1.z, zc1.w};
          unsigned ow[8];
#pragma unroll
          for (int i = 0; i < 8; ++i) { const float y0 = o[2 * i] * rs * nwl[og * 16 + 2 * i] * siluf(bflo(zw[i])), y1 = o[2 * i + 1] * rs * nwl[og * 16 + 2 * i + 1] * siluf(bfhi(zw[i])); ow[i] = cvtpk(y0, y1); }
          bf16* dst = zsrc + (size_t)c * 64 * PP;
          *(v4u*)dst = (v4u){ow[0], ow[1], ow[2], ow[3]}; *(v4u*)(dst + 8) = (v4u){ow[4], ow[5], ow[6], ow[7]}; }
#pragma unroll
        for (int gq = 0; gq < 4; ++gq) { v2u w; w.x = cvtpk(sacc[4 * gq], sacc[4 * gq + 1]); w.y = cvtpk(sacc[4 * gq + 2], sacc[4 * gq + 3]);
            *(LAS v2u*)(lds + O_ST + (32 * vt_ + r32) * PT_ + (32 * kt_ + 8 * gq + 4 * hi) * 2) = w; }
        __syncthreads();
        if (MK_PROBE) { const unsigned pt3 = (unsigned)__builtin_amdgcn_s_memrealtime(); pacc0 += pt1 - pt0; pacc1 += pt2 - pt1; pacc2 += pt3 - pt2; }
    }
    if (MK_PROBE && item == 0 && layer == 0 && tid == 0) { unsigned* ts = (unsigned*)(F.ctl + CW_TS); ts[40] = pacc0; ts[41] = pacc1; ts[42] = pacc2; ts[43] = 0u; }
#undef GLA_LOAD
}
}
#ifndef MK_N_LAUNCHES
#define MK_N_LAUNCHES 1
#endif
constexpr int N_PHASES = 8;

__device__ __forceinline__ void p0_prologue(Frame& F, const Args& args) {
    LAS float* scr = (LAS float*)(F.lds + RING_OFF + F.wave * 16384);
    const int gw = F.vcu * NWAVES + F.wave, NGW = F.G * NWAVES;
    constexpr int NITEMS = CVT_WIN_ITEMS + CVT_WOUT_ITEMS;
    for (int it = gw; it < NITEMS; it += NGW) {
        if (it < CVT_WIN_ITEMS) cvt_win_item(argp(args, I_WIN), argp(args, I_NORMW), WSP(F, WS_WIN), scr, it, F.lane);
        else cvt_wout_item(argp(args, I_WOUT), argp(args, I_SSDNW), WSP(F, WS_WOUT), scr, it - CVT_WIN_ITEMS, F.lane);
    }
    float* ssq0 = (float*)(F.ctl + CW_SSQX);
    for (int m = gw; m < T; m += NGW) row_to_bf16(argp(args, I_X) + (size_t)m * DM, WSP(F, WS_XB) + (size_t)m * DM, ssq0 + m, F.lane);
}

#define STAMP_MAX(k) do { if (MK_PROBE && F.tid == 0) atomicMax((unsigned*)(F.ctl + CW_TS + 32 + (k)), (unsigned)__builtin_amdgcn_s_memrealtime()); } while (0)
#define QUEUE_LOOP(qword, nitems, body) for (;;) { __syncthreads(); if (F.tid == 0) F.MISC[16] = __hip_atomic_fetch_add((unsigned*)(F.ctl + (qword)), 1u, RLX_AGENT); __syncthreads(); \
        const int item = (int)F.MISC[16]; if (item >= (nitems)) break; body; }
__device__ __forceinline__ void p_mixers(Frame& F, const Args& args, int layer) {
    constexpr int N_SSD = 128, N_GLA = 32, N_SB = 512;
    const int q0 = CW_Q + 256 * layer;
    QUEUE_LOOP(q0, N_GLA, gla::gla_item(F, args, item, layer)); if (layer == 0) STAMP_MAX(0);
    QUEUE_LOOP(q0 + 64, N_SSD, ssd::ssd_item(F, args, item, layer)); if (layer == 0) STAMP_MAX(1);
    QUEUE_LOOP(q0 + 128, N_SB, sba::sb_item(F, item)); if (layer == 0) STAMP_MAX(2);
    LAS float* scr = (LAS float*)(F.lds + RING_OFF + F.wave * 16384);
    if (layer == 0) { QUEUE_LOOP(q0 + 192, CVT_WIN_ITEMS / 8, cvt_win_item(argp(args, I_WIN) + (size_t)DM * NPROJ, argp(args, I_NORMW) + DM, WSP(F, WS_WIN), scr, item * 8 + F.wave, F.lane)); }
    else { QUEUE_LOOP(q0 + 192, CVT_WOUT_ITEMS / 8, cvt_wout_item(argp(args, I_WOUT) + (size_t)DI * DM, argp(args, I_SSDNW) + 1024, WSP(F, WS_WOUT), scr, item * 8 + F.wave, F.lane)); }
}

__global__ void __launch_bounds__(NWAVES * 64, 2) mk_fwd(Args args) {
    extern __shared__ __attribute__((aligned(16))) unsigned char lds[];
    Frame F;
    F.lds = (LAS unsigned char*)lds;
    F.MISC = (volatile LAS unsigned*)(F.lds + MISC_OFF);
    F.tid = threadIdx.x; F.lane = F.tid & 63; F.wave = __builtin_amdgcn_readfirstlane(F.tid >> 6);
    F.G = gridDim.x; { const int bx = blockIdx.x; F.vcu = (F.G % 8 == 0) ? (bx % 8) * (F.G / 8) + bx / 8 : bx; }
    F.ws = args.ws;
    F.ctl = (gu32*)(F.ws + WS_CTL);
    for (int u = F.tid; u < (LDS_BYTES - LDSCTL_OFF) / 4; u += NWAVES * 64) ((LAS unsigned*)(F.lds + LDSCTL_OFF))[u] = 0u;
    __syncthreads();
    XcdBarrier bar; bar.bar = (unsigned*)(F.ctl + CW_BAR); bar.x = 0; bar.st = nullptr;
    if (MK_N_LAUNCHES == 1) bar = xcd_barrier_post((unsigned*)(F.ctl + CW_BAR), F.MISC + 8);
#define GRID_BAR() do { if (MK_N_LAUNCHES == 1) xcd_barrier<false>(bar); } while (0)
    const int lo = args.ph_lo, hi = args.ph_hi;
    int n_stamp = 0;
#define STAMP() do { if (MK_PROBE && blockIdx.x == 0 && F.tid == 0) __hip_atomic_store((unsigned*)(F.ctl + CW_TS + n_stamp), (unsigned)__builtin_amdgcn_s_memrealtime(), RLX_AGENT); ++n_stamp; } while (0)
    STAMP();
#define IN(k) (lo <= (k) && (k) < hi)
    if (IN(0)) { p0_prologue(F, args); if (MK_N_LAUNCHES == 1) xcd_barrier<true>(bar); } STAMP();
#pragma unroll 1
    for (int layer = 0; layer < DEPTH; ++layer) {
        float* ssq_in = (float*)(F.ctl + CW_SSQX) + layer * T;
        float* ssq_next = ssq_in + T;
        if (IN(1 + 3 * layer)) {
            pg8::Gemm g{WSP(F, WS_XB), WSP(F, WS_WIN), T, PP, DM, DM}; pg8::StaticOrder S; S.init(T, PP, F.G, (int)blockIdx.x);
            pg8::EpiProj E{WSP(F, WS_PROJ), PP, ssq_in};
            pg8::gemm_phase<pg8::EpiProj, true, false, DM, DM>(F.lds + RING_OFF, g, S, E, nullptr);
            GRID_BAR();
        } STAMP();
        if (IN(2 + 3 * layer)) { p_mixers(F, args, layer); GRID_BAR(); } STAMP();
        if (IN(3 + 3 * layer)) {
            pg8::Gemm g{WSP(F, WS_PROJ) + PC_Y, WSP(F, WS_WOUT), T, DM, DI, PP}; pg8::StaticOrder S; S.init(T, DM, F.G, (int)blockIdx.x);
            LAS float* hsc = (LAS float*)(F.lds + HSC_OFF);
            { pg8::Unit u; if (S.next(0, u) && F.tid < 256) { const float* sg = (const float*)(F.ctl + CW_SSQG) + ((size_t)layer * T + (size_t)u.pm * 256 + F.tid) * 2;
                  const float r0 = rsqrtf(sg[0] * (1.f / 512.f) + EPS), r1 = rsqrtf(sg[1] * (1.f / 512.f) + EPS); hsc[F.tid * 2 + 0] = r0 / r1; hsc[F.tid * 2 + 1] = r1; } }
            VM_WAIT(); __syncthreads();
            pg8::EpiOut E{layer == 0 ? argp(args, I_X) : args.out, args.out, WSP(F, WS_XB), ssq_next, layer == 0 ? 1 : 0};
            pg8::gemm_phase<pg8::EpiOut, false, true, DI, PP>(F.lds + RING_OFF, g, S, E, hsc);
            GRID_BAR();
        } STAMP();
    }
    if (IN(7)) {
        const float* ssq2 = (const float*)(F.ctl + CW_SSQX) + 2 * T;
        const int gw = F.vcu * NWAVES + F.wave, NGW = F.G * NWAVES;
        float pscale = 1.f;
#if MK_PROBE
        { const unsigned* ts = (const unsigned*)(F.ctl + CW_TS); const int a = MK_PROBE_A, b = MK_PROBE_B;
          const float us = (float)(__hip_atomic_load(ts + a, RLX_AGENT) - __hip_atomic_load(ts + b, RLX_AGENT)) * 0.01f; pscale = 1.f + sqrtf(us * 1e-5f); }
#endif
        for (int m = gw; m < T; m += NGW) {
            const float rs = pscale * rsqrtf(ssq2[m] * (1.f / 1024.f) + EPS);
            GAS f32x4* xr = (GAS f32x4*)(args.out + (size_t)m * DM) + F.lane; const GAS f32x4* wr_ = (const GAS f32x4*)argp(args, I_FINW) + F.lane;
#pragma unroll
            for (int j = 0; j < 4; ++j) { f32x4 v = xr[64 * j]; const f32x4 w = wr_[64 * j]; v = v * rs * w; xr[64 * j] = v; }
        }
    }
#undef IN
#undef GRID_BAR
}

extern "C" void kernel_launch(void* const* d_in, const int* in_sizes, int n_in, void* d_out, int out_size, void* d_ws, size_t ws_size, hipStream_t stream) {
    static int grid = 0;
    if (grid == 0) {
        if (n_in != 14 || in_sizes[0] != T * DM || out_size != T * DM || ws_size < WS_END) { fprintf(stderr, "kernel_launch: unexpected shapes (n_in %d in0 %d out %d ws %zu)\n", n_in, n_in > 0 ? in_sizes[0] : -1, out_size, ws_size); grid = -1; return; }
        int dev = 0, cus = 0, per_cu = 0;
        if (hipGetDevice(&dev) != hipSuccess || hipDeviceGetAttribute(&cus, hipDeviceAttributeMultiprocessorCount, dev) != hipSuccess) { grid = -1; return; }
        if (hipFuncSetAttribute((const void*)mk_fwd, hipFuncAttributeMaxDynamicSharedMemorySize, LDS_BYTES) != hipSuccess) { fprintf(stderr, "kernel_launch: hipFuncSetAttribute failed\n"); grid = -1; return; }
        if (hipOccupancyMaxActiveBlocksPerMultiprocessor(&per_cu, (const void*)mk_fwd, NWAVES * 64, LDS_BYTES) != hipSuccess || per_cu < 1) { fprintf(stderr, "kernel_launch: occupancy query says %d blocks/CU\n", per_cu); }
        (void)hipGetLastError();
        grid = cus;
        if (grid != 256) fprintf(stderr, "kernel_launch: %d CUs (expected 256)\n", grid);
    }
    if (grid < 0) return;
    (void)hipMemsetAsync((char*)d_ws + WS_CTL, 0, CTL_ZERO_BYTES, stream);
    Args a{};
    for (int i = 0; i < 14; ++i) a.in[i] = (const float*)d_in[i];
    a.out = (float*)d_out; a.ws = (unsigned char*)d_ws;
    if (MK_N_LAUNCHES == 1) { a.ph_lo = 0; a.ph_hi = N_PHASES; hipLaunchKernelGGL(mk_fwd, dim3(grid), dim3(NWAVES * 64), LDS_BYTES, stream, a); }
    else for (int p = 0; p < N_PHASES; ++p) { a.ph_lo = p; a.ph_hi = p + 1; hipLaunchKernelGGL(mk_fwd, dim3(grid), dim3(NWAVES * 64), LDS_BYTES, stream, a); }
}
```

```cpp
#include <hip/hip_runtime.h>
#include <cstdio>
#include <cstdint>
namespace pg8 {
#define PG8_LAS __attribute__((address_space(3)))
typedef unsigned short bf16_t;
typedef short bf16x8 __attribute__((ext_vector_type(8)));
typedef float f32x4 __attribute__((ext_vector_type(4)));
typedef unsigned u32x4 __attribute__((ext_vector_type(4)));
typedef unsigned u32x2 __attribute__((ext_vector_type(2)));
constexpr int BM = 256, BK = 64, HALF = 128, HTB = HALF * BK * 2  , STAGE_BYTES = 8 * HTB, NXCD = 8, WGM = 8;

__host__ __device__ __forceinline__ int lds_byte(int r, int c) { const int st = (r >> 4) * 2 + (c >> 5), rr = r & 15, cc = c & 31, ob = rr * 64 + cc * 2; return st * 1024 + (ob ^ (((ob >> 9) & 1) << 5)); }
__host__ __device__ __forceinline__ void stage_rc(int b, int& R, int& C) { const int st = b / 1024, sb = b % 1024, swz = sb ^ (((sb >> 9) & 1) << 5); R = (st >> 1) * 16 + swz / 64; C = (st & 1) * 32 + (swz % 64) / 2; }
__host__ __device__ __forceinline__ int perm32(int rho) { const int n = rho >> 4, i = rho & 15; return 8 * (i >> 2) + 4 * n + (i & 3); }

struct Unit { int pm, pn; };
struct Gemm { const bf16_t* A; const bf16_t* Bt; int M, N, K, lda; };

struct StaticOrder {
    int nM, nN, nwg, G, c;
    __host__ __device__ void init(int M, int N, int G_, int c_) { nM = M / BM; nN = N / BM; nwg = nM * nN; G = G_; c = c_; }
    __host__ __device__ bool next(int i, Unit& u) const {
        const long L = (long)i * G + c; if (L >= nwg) return false;
        int wgid = (int)L; { const int q = nwg / NXCD, r = nwg % NXCD, xcd = wgid % NXCD, off = wgid / NXCD; wgid = (xcd < r ? xcd * (q + 1) : r * (q + 1) + (xcd - r) * q) + off; }
        const int nig = WGM * nN, gid = wgid / nig, fm = gid * WGM, gsz = (nM - fm) < WGM ? (nM - fm) : WGM;
        u.pm = fm + ((wgid % nig) % gsz); u.pn = (wgid % nig) / gsz; return true;
    }
};

__device__ __forceinline__ unsigned cvt_pk_bf16(float lo, float hi) { unsigned r; asm volatile("v_cvt_pk_bf16_f32 %0, %1, %2" : "=v"(r) : "v"(lo), "v"(hi)); return r; }

template <class Epi, bool ALIGN_EPI, bool HORNER, int K, int lda>
__device__ __forceinline__ void gemm_phase(PG8_LAS unsigned char* lds, const Gemm g, const StaticOrder& S, const Epi& E, const PG8_LAS float* hsc) {
    int tid_ = threadIdx.x; asm volatile("" : "+v"(tid_));
    const int tid = tid_, wid = __builtin_amdgcn_readfirstlane(tid >> 6), lane = tid & 63, wr = wid >> 2, wc = wid & 3, fr = lane & 15, fq = lane >> 4;
    constexpr int nt = K / BK;
    unsigned voffA[2], voffB[2];
#pragma unroll
    for (int i = 0; i < 2; ++i) { int R, C; stage_rc(tid * 16 + i * 8192, R, C); const int Rb = Epi::PERM ? ((R & ~31) + perm32(R & 31)) : R;
        voffA[i] = (unsigned)(R * lda + C) * 2u; voffB[i] = (unsigned)(Rb * K + C) * 2u; }
    constexpr size_t kstep = (size_t)(BK * 2);
    constexpr size_t hstepA = (size_t)HALF * lda * 2, hstepB = (size_t)HALF * K * 2;
    constexpr size_t tstepA = 2 * hstepA, tstepB = 2 * hstepB;
    const unsigned ldsw = (unsigned)wid * 1024u;
    const int aoff = lds_byte(wr * 64 + fr, fq * 8), boff = lds_byte(wc * 32 + fr, fq * 8);
#define PG8_SA(b, h) (((b) * 2 + (h)) * HTB)
#define PG8_SB(b, h) ((4 + (b) * 2 + (h)) * HTB)
#define PG8_STAGE(bufoff, gbase, voff) do { _Pragma("unroll") for (int _i = 0; _i < 2; ++_i) \
        __builtin_amdgcn_global_load_lds((const unsigned*)((const char*)(gbase) + (voff)[_i]), (PG8_LAS unsigned*)(lds + (bufoff) + ldsw + _i * 8192), 16, 0, 0); } while (0)
#define PG8_LDA(dst, b, h) do { _Pragma("unroll") for (int m = 0; m < 4; ++m) _Pragma("unroll") for (int k = 0; k < 2; ++k) dst[m][k] = *(const PG8_LAS bf16x8*)(lds + PG8_SA(b, h) + aoff + m * 2048 + k * 1024); } while (0)
#define PG8_LDB(dst, b, h) do { _Pragma("unroll") for (int n = 0; n < 2; ++n) _Pragma("unroll") for (int k = 0; k < 2; ++k) dst[n][k] = *(const PG8_LAS bf16x8*)(lds + PG8_SB(b, h) + boff + n * 2048 + k * 1024); } while (0)
#define PG8_MMA(ai, bj, At, Bt) do { __builtin_amdgcn_s_setprio(1); _Pragma("unroll") for (int m = 0; m < 4; ++m) _Pragma("unroll") for (int n = 0; n < 2; ++n) _Pragma("unroll") for (int k = 0; k < 2; ++k) \
        acc[ai][bj][m][n] = __builtin_amdgcn_mfma_f32_16x16x32_bf16(Bt[n][k], At[m][k], acc[ai][bj][m][n], 0, 0, 0); __builtin_amdgcn_s_setprio(0); } while (0)
#define PG8_WAIT_V(n) asm volatile("s_waitcnt vmcnt(" #n ")" ::: "memory")
#define PG8_WAIT_L(n) asm volatile("s_waitcnt lgkmcnt(" #n ")" ::: "memory")
#define PG8_BAR __builtin_amdgcn_s_barrier()
#define PG8_SCHED __builtin_amdgcn_sched_barrier(0)
    Unit cur, nxt; int ui = 0;
    if (!S.next(0, cur)) return;
    f32x4 acc[2][2][4][2];
#pragma unroll
    for (int a = 0; a < 2; ++a)
#pragma unroll
        for (int b = 0; b < 2; ++b)
#pragma unroll
            for (int m = 0; m < 4; ++m)
#pragma unroll
                for (int n = 0; n < 2; ++n) acc[a][b][m][n] = (f32x4){0.f, 0.f, 0.f, 0.f};
    bf16x8 At[4][2], B0[2][2], B1[2][2];
    const char* cA = (const char*)g.A + (size_t)cur.pm * tstepA; const char* cB = (const char*)g.Bt + (size_t)cur.pn * tstepB;
    PG8_STAGE(PG8_SB(0, 0), cB, voffB); PG8_STAGE(PG8_SB(0, 1), cB + hstepB, voffB); PG8_STAGE(PG8_SA(0, 0), cA, voffA); PG8_STAGE(PG8_SA(0, 1), cA + hstepA, voffA);
    if (wr == 1) PG8_BAR;
    PG8_WAIT_V(2); PG8_BAR;
    PG8_STAGE(PG8_SB(1, 0), cB + kstep, voffB); PG8_STAGE(PG8_SA(1, 0), cA + kstep, voffA); PG8_STAGE(PG8_SB(1, 1), cB + hstepB + kstep, voffB);
    PG8_WAIT_V(6); PG8_BAR;
    for (;;) {
        const bool has_next = S.next(ui + 1, nxt);
        const char* nA = has_next ? (const char*)g.A + (size_t)nxt.pm * tstepA : cA; const char* nB = has_next ? (const char*)g.Bt + (size_t)nxt.pn * tstepB : cB;
        for (int t = 0; t < nt; t += 2) {
            const bool last = (t == nt - 2);
            const char* a1 = cA + (size_t)(t + 1) * kstep;
            const char* a2 = last ? nA : cA + (size_t)(t + 2) * kstep; const char* b2 = last ? nB : cB + (size_t)(t + 2) * kstep;
            const char* a3 = a2 + kstep; const char* b3 = b2 + kstep;
            if constexpr (HORNER) {
                if (t == 8 || t == 16) { const int hc = (t == 8) ? 0 : 1;
#pragma unroll
                    for (int ai = 0; ai < 2; ++ai)
#pragma unroll
                        for (int m = 0; m < 4; ++m) { const float f = hsc[(ai * HALF + wr * 64 + m * 16 + fr) * 2 + hc];
#pragma unroll
                            for (int bj = 0; bj < 2; ++bj)
#pragma unroll
                                for (int n = 0; n < 2; ++n) acc[ai][bj][m][n] = acc[ai][bj][m][n] * f; }
                    PG8_WAIT_L(0); PG8_SCHED; }
            }
            PG8_LDB(B0, 0, 0); PG8_LDB(B1, 0, 1); PG8_SCHED; PG8_LDA(At, 0, 0); PG8_STAGE(PG8_SA(1, 1), a1 + hstepA, voffA);
            PG8_WAIT_V(8); PG8_WAIT_L(0); PG8_BAR; PG8_MMA(0, 0, At, B0); PG8_MMA(0, 1, At, B1); PG8_BAR; PG8_SCHED;
            PG8_LDA(At, 0, 1); PG8_STAGE(PG8_SB(0, 0), b2, voffB); PG8_STAGE(PG8_SB(0, 1), b2 + hstepB, voffB); PG8_STAGE(PG8_SA(0, 0), a2, voffA);
            PG8_WAIT_V(8); PG8_WAIT_L(0); PG8_BAR; PG8_MMA(1, 0, At, B0); PG8_MMA(1, 1, At, B1); PG8_BAR; PG8_SCHED;
            PG8_LDB(B0, 1, 0); PG8_LDB(B1, 1, 1); PG8_SCHED; PG8_LDA(At, 1, 0); PG8_STAGE(PG8_SA(0, 1), a2 + hstepA, voffA);
            PG8_WAIT_V(8); PG8_WAIT_L(0); PG8_BAR; PG8_MMA(0, 0, At, B0); PG8_MMA(0, 1, At, B1); PG8_BAR; PG8_SCHED;
            PG8_LDA(At, 1, 1); PG8_STAGE(PG8_SB(1, 0), b3, voffB); PG8_STAGE(PG8_SB(1, 1), b3 + hstepB, voffB); PG8_STAGE(PG8_SA(1, 0), a3, voffA);
            PG8_WAIT_V(8); PG8_WAIT_L(0); PG8_BAR; PG8_MMA(1, 0, At, B0); PG8_MMA(1, 1, At, B1); PG8_BAR; PG8_SCHED;
        }
        if constexpr (ALIGN_EPI) { if (wr == 0) PG8_BAR; }
        if constexpr (!Epi::AFTER_DRAIN) { E(acc, cur, wr, wc, fr, fq); }
        if (!has_next) break;
#pragma unroll
        for (int a = 0; a < 2; ++a)
#pragma unroll
            for (int b = 0; b < 2; ++b)
#pragma unroll
                for (int m = 0; m < 4; ++m)
#pragma unroll
                    for (int n = 0; n < 2; ++n) acc[a][b][m][n] = (f32x4){0.f, 0.f, 0.f, 0.f};
        cur = nxt; cA = nA; cB = nB; ++ui;
        if constexpr (ALIGN_EPI) { if (wr == 1) PG8_BAR; }
    }
    PG8_WAIT_V(0);
    if constexpr (!ALIGN_EPI) { if (wr == 0) PG8_BAR; }
    PG8_BAR;
    if constexpr (Epi::AFTER_DRAIN) { E.fused(acc, cur, wr, wc, fr, fq); }
#undef PG8_SA
#undef PG8_SB
#undef PG8_STAGE
#undef PG8_LDA
#undef PG8_LDB
#undef PG8_MMA
#undef PG8_WAIT_V
#undef PG8_WAIT_L
#undef PG8_BAR
#undef PG8_SCHED
}
}
#ifndef MK_PROBE
#define MK_PROBE 0
#endif
constexpr int NWAVES = 8;
constexpr int BATCH = 8, SEQ = 2048, T = BATCH * SEQ, DM = 1024, DEPTH = 2;
constexpr int NPROJ = 6176, PP = 6400  , DI = 2048;
constexpr float EPS = 1e-6f;
constexpr int PC_Y = 0;
constexpr int PC_SSDZ = 0, PC_SBZ = 1024, PC_GZ = 1536;
constexpr int PC_SBQ = 2048, PC_SBK = 2560, PC_SBV = 3072;
constexpr int PC_XBC = 3584  , PC_GQ = 5120, PC_GK = 5376, PC_GV = 5632, PC_DT = 6144, PC_GLR = 6160;
constexpr int NMAIN = 6144;
__host__ __device__ __forceinline__ int proj_orig_col(int n) {
    if (n < 1024) return 2048 + n;
    if (n < 1536) return 1536 + (n - 1024);
    if (n < 2048) return 5648 + (n - 1536);
    if (n < 3584) return n - 2048;
    if (n < 5120) return 3072 + (n - 3584);
    if (n < 6144) return 4624 + (n - 5120);
    if (n < 6160) return 4608 + (n - 6144);
    return n;
}
__host__ __device__ __forceinline__ int wout_src_row(int kk) { return kk < 1024 ? 512 + kk : (kk < 1536 ? kk - 1024 : kk); }

constexpr size_t MiB = 1u << 20;
constexpr size_t WS_CTL = 0, CTL_ZERO_BYTES = 1 * MiB;
constexpr size_t WS_WIN = 1 * MiB;
constexpr size_t WS_WOUT = 14 * MiB;
constexpr size_t WS_XB = 18 * MiB;
constexpr size_t WS_PROJ = 50 * MiB;
constexpr size_t WS_HALO = 250 * MiB;
constexpr size_t WS_EG = 253 * MiB;
constexpr size_t WS_END = 254 * MiB;
static_assert(WS_WIN + (size_t)PP * DM * 2 <= WS_WOUT && WS_WOUT + (size_t)DM * DI * 2 <= WS_XB && WS_XB + (size_t)T * DM * 2 <= WS_PROJ && WS_PROJ + (size_t)T * PP * 2 <= WS_END, "ws map");
constexpr int CW_TMO = 0, CW_CODE = 1;
constexpr int CW_BAR = 4096;
constexpr int CW_TS = 6144;
constexpr int CW_Q = 8192;
constexpr int CW_SSQX = 32768;
constexpr int CW_SSQG = CW_SSQX + 3 * T;
static_assert((CW_SSQG + 2 * T * 2) * 4 <= (int)CTL_ZERO_BYTES, "CTL");

constexpr int RING_OFF = 0, RING_BYTES = 131072;
constexpr int HSC_OFF = RING_BYTES;
constexpr int LDSCTL_OFF = HSC_OFF + 2048, MISC_OFF = LDSCTL_OFF + 320;
constexpr int LDS_BYTES = 147456;
static_assert(MISC_OFF + 128 <= LDS_BYTES, "LDS map");

#define GAS __attribute__((address_space(1)))
#define LAS __attribute__((address_space(3)))
typedef unsigned short bf16;
typedef unsigned v4u __attribute__((ext_vector_type(4)));
typedef unsigned v2u __attribute__((ext_vector_type(2)));
typedef float f32x4 __attribute__((ext_vector_type(4)));
typedef GAS unsigned gu32;
#define RLX_AGENT __ATOMIC_RELAXED, __HIP_MEMORY_SCOPE_AGENT
#define LDS_WAIT() asm volatile("s_waitcnt lgkmcnt(0)" ::: "memory")
#define VM_WAIT() asm volatile("s_waitcnt vmcnt(0)" ::: "memory")
__device__ __forceinline__ unsigned f2bf(float f) { unsigned u = __builtin_bit_cast(unsigned, f); return (u + 0x7fffu + ((u >> 16) & 1u)) >> 16; }
__device__ __forceinline__ unsigned pk2(float lo, float hi) { return f2bf(lo) | (f2bf(hi) << 16); }
__device__ __forceinline__ float bf2f(bf16 v) { return __builtin_bit_cast(float, (unsigned)v << 16); }
__device__ __forceinline__ float bflo(unsigned w) { return __builtin_bit_cast(float, w << 16); }
__device__ __forceinline__ float bfhi(unsigned w) { return __builtin_bit_cast(float, w & 0xffff0000u); }
__device__ __forceinline__ float siluf(float x) { return x / (1.f + __expf(-x)); }
__device__ __forceinline__ float softplusf(float x) { return fmaxf(x, 0.f) + log1pf(expf(-fabsf(x))); }
__device__ __forceinline__ float logsigf(float x) { return fminf(x, 0.f) - log1pf(expf(-fabsf(x))); }

typedef short bf16x8_t __attribute__((ext_vector_type(8)));
typedef short v4i16_t __attribute__((ext_vector_type(4)));
__device__ __forceinline__ bf16x8_t tr_frag(const LAS unsigned char* img, int pitch, int row0, int col0, int lane) {
    const LAS unsigned char* p = img + (row0 + ((lane & 15) >> 2)) * pitch + (col0 + 16 * ((lane >> 4) & 1) + 4 * (lane & 3)) * 2;
    const v4i16_t lo = __builtin_amdgcn_ds_read_tr16_b64_v4i16((LAS v4i16_t*)p), hi = __builtin_amdgcn_ds_read_tr16_b64_v4i16((LAS v4i16_t*)(p + 4 * pitch));
    return (bf16x8_t){lo[0], lo[1], lo[2], lo[3], hi[0], hi[1], hi[2], hi[3]};
}
#define DPP_ADD(s, ctrl, rmask) s += __builtin_bit_cast(float, __builtin_amdgcn_update_dpp(0, __builtin_bit_cast(int, s), ctrl, rmask, 0xf, false))
__device__ __forceinline__ float wave_scan(float s) {
    DPP_ADD(s, 0x111, 0xf); DPP_ADD(s, 0x112, 0xf); DPP_ADD(s, 0x114, 0xf); DPP_ADD(s, 0x118, 0xf);
    DPP_ADD(s, 0x142, 0xa); DPP_ADD(s, 0x143, 0xc);
    return s;
}

#define XB_TMO      128
#define XB_XCNT(j)  (256  + 64 * (j))
#define XB_XSUB(j)  (1280 + 64 * (j))
#define XB_XGEN(j)  (2304 + 64 * (j))
#define XB_TOP      3328
#define XB_TOPGEN   3392
#define XCD_BAR_WORDS 3456
#define XB_SPIN_CAP (1u << 22)
__device__ __forceinline__ unsigned xb_ld(unsigned* p)              { return __hip_atomic_load(p, __ATOMIC_RELAXED, __HIP_MEMORY_SCOPE_AGENT); }
__device__ __forceinline__ unsigned xb_add(unsigned* p, unsigned v) { return __hip_atomic_fetch_add(p, v, __ATOMIC_RELAXED, __HIP_MEMORY_SCOPE_AGENT); }
__device__ __forceinline__ unsigned xb_xcc_id() { return (unsigned)__builtin_amdgcn_s_getreg((3 << 11) | 20) & 0xFu; }
#define XB_SPIN(cond, bar) do { unsigned _sp = 0; while (cond) { __builtin_amdgcn_s_sleep(1); \
    if ((++_sp & 255u) == 0u) { if (xb_ld(&(bar)[XB_TMO])) break; if (_sp > XB_SPIN_CAP) { atomicAdd(&(bar)[XB_TMO], 1u); break; } } } } while (0)
struct XcdBarrier { unsigned* bar; unsigned x; volatile LAS unsigned* st; };
__device__ __forceinline__ XcdBarrier xcd_barrier_post(unsigned* bar, volatile LAS unsigned* st) {
    XcdBarrier b; b.bar = bar; b.x = xb_xcc_id(); b.st = st;
    if (threadIdx.x == 0) (void)xb_add(&bar[XB_XCNT(b.x)], 1u);
    return b;
}
__device__ __forceinline__ void xcd_barrier_complete(unsigned* bar, unsigned x, unsigned& nloc, unsigned& nx) {
    const unsigned G = gridDim.x * gridDim.y * gridDim.z;
    unsigned sum, cnt, sp = 0u;
    for (;;) {
        sum = 0u; cnt = 0u;
#pragma unroll 1
        for (unsigned j = 0; j < 16; ++j) { const unsigned c = xb_ld(&bar[XB_XCNT(j)]); sum += c; cnt += (c > 0u) ? 1u : 0u; }
        if (sum == G) break;
        __builtin_amdgcn_s_sleep(1);
        if ((++sp & 255u) == 0u) { if (xb_ld(&bar[XB_TMO])) break; if (sp > XB_SPIN_CAP) { atomicAdd(&bar[XB_TMO], 1u); break; } }
    }
    const unsigned mine = xb_ld(&bar[XB_XCNT(x)]);
    nloc = mine > 0u ? mine : 1u; nx = cnt > 0u ? cnt : 1u;
}
template <bool FIRST> __device__ __forceinline__ void xcd_barrier(const XcdBarrier& b) {
    asm volatile("s_waitcnt vmcnt(0)" ::: "memory");
    __syncthreads();
    if (threadIdx.x == 0) {
        unsigned* bar = b.bar;
        __builtin_amdgcn_s_waitcnt(0);
        unsigned nloc = b.st[0], nx = b.st[1];
        if constexpr (FIRST) { if (nloc == 0u) { xcd_barrier_complete(bar, b.x, nloc, nx); b.st[0] = nloc; b.st[1] = nx; } }
        const unsigned old = xb_add(&bar[XB_XSUB(b.x)], 1u);
        const unsigned gen = old / nloc;
        if (old + 1u == (gen + 1u) * nloc) {
            __builtin_amdgcn_fence(__ATOMIC_RELEASE, "agent");
            asm volatile("s_waitcnt vmcnt(0)" ::: "memory");
            const unsigned og = xb_add(&bar[XB_TOP], 1u);
            const unsigned tg = og / nx;
            if (og + 1u == (tg + 1u) * nx) xb_add(&bar[XB_TOPGEN], 1u);
            else XB_SPIN(xb_ld(&bar[XB_TOPGEN]) == tg, bar);
            __builtin_amdgcn_fence(__ATOMIC_ACQUIRE, "agent");
            xb_add(&bar[XB_XGEN(b.x)], 1u);
            asm volatile("s_waitcnt vmcnt(0)" ::: "memory");
        } else {
            XB_SPIN(xb_ld(&bar[XB_XGEN(b.x)]) == gen, bar);
            __builtin_amdgcn_fence(__ATOMIC_ACQUIRE, "agent");
            asm volatile("s_waitcnt vmcnt(0)" ::: "memory");
        }
    }
    __syncthreads();
}

namespace pg8 {
#define DPP_MOV(name, ctl) __device__ __forceinline__ int name(int x) { int r; asm("s_nop 1\n\tv_mov_b32_dpp %0, %1 " ctl " row_mask:0xf bank_mask:0xf bound_ctrl:1" : "=v"(r) : "v"(x)); return r; }
__device__ __forceinline__ int dpp_src(int x) { int r; asm volatile("v_mov_b32 %0, %1" : "=v"(r) : "v"(x)); return r; }
DPP_MOV(dpp_ror1, "row_ror:1") DPP_MOV(dpp_ror2, "row_ror:2") DPP_MOV(dpp_ror3, "row_ror:3") DPP_MOV(dpp_shr1, "row_shr:1") DPP_MOV(dpp_shr2, "row_shr:2") DPP_MOV(dpp_shr3, "row_shr:3") DPP_MOV(dpp_shl15, "row_shl:15") DPP_MOV(dpp_shl14, "row_shl:14") DPP_MOV(dpp_shl13, "row_shl:13")
struct EpiProj {
    static constexpr bool PERM = true, AFTER_DRAIN = false;
    bf16_t* O; int ldc; const float* ssq; const float* cw; const float* cb; bf16_t* halo;
    __device__ __forceinline__ void operator()(f32x4 (&acc)[2][2][4][2], const Unit& u, int wr, int wc, int fr, int fq) const {
        const int row0 = u.pm * BM + wr * 64 + fr, col0 = u.pn * BM + wc * 32 + 8 * fq;
#pragma unroll
        for (int ai = 0; ai < 2; ++ai)
#pragma unroll
            for (int m = 0; m < 4; ++m) { const float rs = rsqrtf(ssq[row0 + ai * HALF + m * 16] * (1.0f / 1024.0f) + 1e-6f);
#pragma unroll
                for (int bj = 0; bj < 2; ++bj) { acc[ai][bj][m][0] = acc[ai][bj][m][0] * rs; acc[ai][bj][m][1] = acc[ai][bj][m][1] * rs; } }
        if (u.pn >= 14 && u.pn < 20) {
#pragma unroll
            for (int bj = 0; bj < 2; ++bj) {
                const int ch0 = col0 + bj * HALF - 3584;
                if (fr >= 13) {
#pragma unroll
                    for (int ai = 0; ai < 2; ++ai) { const f32x4 r0 = acc[ai][bj][3][0], r1 = acc[ai][bj][3][1];
                        u32x4 w; w.x = cvt_pk_bf16(r0[0], r0[1]); w.y = cvt_pk_bf16(r0[2], r0[3]); w.z = cvt_pk_bf16(r1[0], r1[1]); w.w = cvt_pk_bf16(r1[2], r1[3]);
                        const int blk = (u.pm * BM + ai * HALF + wr * 64) >> 6;
                        *(u32x4*)(halo + ((size_t)blk * 3 + (fr - 13)) * 1536 + ch0) = w; } }
#pragma unroll
                for (int n = 0; n < 2; ++n) {
                    asm volatile("" ::: "memory");
                    const f32x4 w0 = *(const f32x4*)(cw + 0 * 1536 + ch0 + 4 * n), w1 = *(const f32x4*)(cw + 1 * 1536 + ch0 + 4 * n), w2 = *(const f32x4*)(cw + 2 * 1536 + ch0 + 4 * n),
                                w3 = *(const f32x4*)(cw + 3 * 1536 + ch0 + 4 * n), bb = *(const f32x4*)(cb + ch0 + 4 * n);
#pragma unroll
                    for (int ai = 0; ai < 2; ++ai) {
                        float out[4][4], raw[4][4];
#pragma unroll
                        for (int m = 0; m < 4; ++m) { const f32x4 t = acc[ai][bj][m][n]; raw[m][0] = t[0]; raw[m][1] = t[1]; raw[m][2] = t[2]; raw[m][3] = t[3]; }
#pragma unroll
                        for (int e = 0; e < 4; ++e)
#pragma unroll
                            for (int m = 0; m < 4; ++m) {
                                const float vm = raw[m][e];
                                const int cur = __builtin_bit_cast(int, vm);
                                int prv = 0; if (m > 0) prv = __builtin_bit_cast(int, raw[m > 0 ? m - 1 : 0][e]);
                                const float p1 = __builtin_bit_cast(float, dpp_ror1(fr >= 15 ? prv : cur));
                                const float p2 = __builtin_bit_cast(float, dpp_ror2(fr >= 14 ? prv : cur));
                                const float p3 = __builtin_bit_cast(float, dpp_ror3(fr >= 13 ? prv : cur));
                                const float s = bb[e] + w3[e] * vm + w2[e] * p1 + w1[e] * p2 + w0[e] * p3;
                                const float y = s * __builtin_amdgcn_rcpf(1.f + __builtin_amdgcn_exp2f(-1.4426950408889634f * s));
                                out[m][e] = (m == 0 && fr < 3) ? vm : y;
                            }
#pragma unroll
                        for (int m = 0; m < 4; ++m) { u32x2 w; w.x = cvt_pk_bf16(out[m][0], out[m][1]); w.y = cvt_pk_bf16(out[m][2], out[m][3]);
                            *(u32x2*)(O + (size_t)(row0 + ai * HALF + m * 16) * ldc + col0 + bj * HALF + 4 * n) = w; }
                    }
                    __builtin_amdgcn_sched_barrier(0);
                }
            }
            return;
        }
#pragma unroll
        for (int ai = 0; ai < 2; ++ai)
#pragma unroll
            for (int m = 0; m < 4; ++m) { const int row = row0 + ai * HALF + m * 16; bf16_t* rowp = O + (size_t)row * ldc + col0;
#pragma unroll
                for (int bj = 0; bj < 2; ++bj) { const f32x4 v0 = acc[ai][bj][m][0], v1 = acc[ai][bj][m][1];
                    u32x4 w; w.x = cvt_pk_bf16(v0[0], v0[1]); w.y = cvt_pk_bf16(v0[2], v0[3]); w.z = cvt_pk_bf16(v1[0], v1[1]); w.w = cvt_pk_bf16(v1[2], v1[3]);
                    *(u32x4*)(rowp + bj * HALF) = w; } }
    }
};
struct EpiOut {
    static constexpr bool PERM = false, AFTER_DRAIN = true;
    const float* xin; float* xout; bf16_t* xb; float* ssq; int write_xb;
    __device__ __forceinline__ void fused(const f32x4 (&acc)[2][2][4][2], const Unit& u, int wr, int wc, int fr, int fq) const {
        const int col0 = u.pn * BM + wc * 32 + 4 * fq;
#pragma unroll
        for (int ai = 0; ai < 2; ++ai)
#pragma unroll
            for (int m = 0; m < 4; ++m) { const int row = u.pm * BM + ai * HALF + wr * 64 + m * 16 + fr; const size_t off = (size_t)row * 1024 + col0; float s = 0.f;
#pragma unroll
                for (int bj = 0; bj < 2; ++bj)
#pragma unroll
                    for (int n = 0; n < 2; ++n) { const f32x4 o = *(const f32x4*)(xin + off + bj * HALF + n * 16) + acc[ai][bj][m][n];
                        *(f32x4*)(xout + off + bj * HALF + n * 16) = o; s += (o[0] * o[0] + o[1] * o[1]) + (o[2] * o[2] + o[3] * o[3]);
                        if (write_xb) { u32x2 w; w.x = cvt_pk_bf16(o[0], o[1]); w.y = cvt_pk_bf16(o[2], o[3]); *(u32x2*)(xb + off + bj * HALF + n * 16) = w; } }
                s += __shfl_xor(s, 16); s += __shfl_xor(s, 32);
                if (fq == 0) atomicAdd(ssq + row, s);
                asm volatile("" ::: "memory"); }
    }
};
}

struct Frame {
    LAS unsigned char* lds;
    volatile LAS unsigned* MISC;
    gu32* ctl;
    int tid, lane, wave, vcu, G;
    unsigned char* ws;
};
struct Args { const float* in[14]; float* out; unsigned char* ws; int ph_lo, ph_hi; };
enum { I_X = 0, I_NORMW, I_WIN, I_CONVW, I_CONVB, I_DTB, I_ALOG, I_SSDD, I_SSDNW, I_GATEW, I_GATEB, I_GLANW, I_WOUT, I_FINW };
#define WSP(F, off) ((bf16*)((F).ws + (off)))
__device__ __forceinline__ const float* argp(const Args& a, int i) { asm volatile("" : "+s"(i)); return a.in[i]; }

__device__ __forceinline__ float wave_sum(float v) {
#pragma unroll
    for (int o = 1; o < 64; o <<= 1) v += __shfl_xor(v, o);
    return v;
}
__device__ __forceinline__ void cvt_win_item(const float* W, const float* nw, bf16* WT, LAS float* scr, int item, int lane) {
    const int nblk = PP / 32, kb = item / nblk, nb = item % nblk, k0 = 64 * kb, n0 = 32 * nb;
    const int n = n0 + (lane & 31); const bool valid = n < NPROJ; const int oc = valid ? proj_orig_col(n) : 0;
    const float cs = (n >= PC_SBQ && n < PC_SBQ + 512) ? 0.18033688011112042f : ((n >= PC_GQ && n < PC_GQ + 256) ? 0.125f : 1.f);
#pragma unroll 8
    for (int i = 0; i < 32; ++i) { const int kk = 2 * i + (lane >> 5); scr[kk * 33 + (lane & 31)] = valid ? W[(size_t)(k0 + kk) * NPROJ + oc] * nw[k0 + kk] * cs : 0.f; }
    LDS_WAIT(); asm volatile("" ::: "memory");
    const int c = lane & 7;
#pragma unroll
    for (int j = 0; j < 4; ++j) { const int nn = (lane >> 3) + 8 * j; const LAS float* s = scr + (8 * c) * 33 + nn;
        v4u o; o.x = pk2(s[0 * 33], s[1 * 33]); o.y = pk2(s[2 * 33], s[3 * 33]); o.z = pk2(s[4 * 33], s[5 * 33]); o.w = pk2(s[6 * 33], s[7 * 33]);
        *(GAS v4u*)(WT + (size_t)(n0 + nn) * DM + k0 + 8 * c) = o; }
    LDS_WAIT(); asm volatile("" ::: "memory");
}
__device__ __forceinline__ void cvt_wout_item(const float* W, const float* snw, bf16* WT, LAS float* scr, int item, int lane) {
    const int nblk = DM / 32, kb = item / nblk, nb = item % nblk, k0 = 64 * kb, n0 = 32 * nb;
#pragma unroll 8
    for (int i = 0; i < 32; ++i) { const int kk = k0 + 2 * i + (lane >> 5); const float sc = kk < 1024 ? snw[kk] : 1.f;
        scr[(2 * i + (lane >> 5)) * 33 + (lane & 31)] = W[(size_t)wout_src_row(kk) * DM + n0 + (lane & 31)] * sc; }
    LDS_WAIT(); asm volatile("" ::: "memory");
    const int c = lane & 7;
#pragma unroll
    for (int j = 0; j < 4; ++j) { const int nn = (lane >> 3) + 8 * j; const LAS float* s = scr + (8 * c) * 33 + nn;
        v4u o; o.x = pk2(s[0 * 33], s[1 * 33]); o.y = pk2(s[2 * 33], s[3 * 33]); o.z = pk2(s[4 * 33], s[5 * 33]); o.w = pk2(s[6 * 33], s[7 * 33]);
        *(GAS v4u*)(WT + (size_t)(n0 + nn) * DI + k0 + 8 * c) = o; }
    LDS_WAIT(); asm volatile("" ::: "memory");
}
constexpr int CVT_WIN_ITEMS = (DM / 64) * (PP / 32);
constexpr int CVT_WOUT_ITEMS = (DI / 64) * (DM / 32);
__device__ __forceinline__ void row_to_bf16(const float* xrow, bf16* orow, float* ssq, int lane) {
    const GAS f32x4* xr = (const GAS f32x4*)xrow + lane;
    f32x4 v[4]; float s = 0.f;
#pragma unroll
    for (int j = 0; j < 4; ++j) { v[j] = xr[64 * j]; s += (v[j].x * v[j].x + v[j].y * v[j].y) + (v[j].z * v[j].z + v[j].w * v[j].w); }
    s = wave_sum(s);
    GAS unsigned long long* o8 = (GAS unsigned long long*)orow + lane;
#pragma unroll
    for (int j = 0; j < 4; ++j) o8[64 * j] = (unsigned long long)pk2(v[j].x, v[j].y) | ((unsigned long long)pk2(v[j].z, v[j].w) << 32);
    if (lane == 0) *ssq = s;
}
namespace sba {
typedef short bf16x8 __attribute__((ext_vector_type(8)));
typedef short s16x4 __attribute__((ext_vector_type(4)));
typedef float f32x16 __attribute__((ext_vector_type(16)));
typedef float f32x2_t __attribute__((ext_vector_type(2)));
typedef __bf16 bf16x2_t __attribute__((ext_vector_type(2)));
__device__ __forceinline__ unsigned cvtpk(float lo, float hi) { f32x2_t v = {lo, hi}; bf16x2_t b = __builtin_convertvector(v, bf16x2_t); return __builtin_bit_cast(unsigned, b); }
__device__ __forceinline__ int crow(int r, int hi) { return (r & 3) + 8 * (r >> 2) + 4 * hi; }
constexpr int L_K = 0, L_V = 8192, L_BUF = 16384, L_FLG = 32768, L_STG = 33792;
constexpr float R_STOP = 8.67361738e-19f;

__device__ __forceinline__ void pv(f32x16* o, int vb, bf16x8 pa0, bf16x8 pa1, bf16x8 pa2, bf16x8 pa3) {
#pragma unroll
    for (int d0 = 0; d0 < 2; ++d0) { s16x4 lo[4], hi[4];
#pragma unroll
        for (int ks = 0; ks < 4; ++ks) {
            asm volatile("ds_read_b64_tr_b16 %0,%1 offset:%c2" : "=&v"(lo[ks]) : "v"(vb), "i"(d0 * 4096 + ks * 1024) : "memory");
            asm volatile("ds_read_b64_tr_b16 %0,%1 offset:%c2" : "=&v"(hi[ks]) : "v"(vb), "i"(d0 * 4096 + ks * 1024 + 512) : "memory"); }
        asm volatile("s_waitcnt lgkmcnt(0)" ::: "memory"); __builtin_amdgcn_sched_barrier(0);
#define SBA_PK(k) (bf16x8){lo[k][0], lo[k][1], lo[k][2], lo[k][3], hi[k][0], hi[k][1], hi[k][2], hi[k][3]}
        o[d0] = __builtin_amdgcn_mfma_f32_32x32x16_bf16(pa0, SBA_PK(0), o[d0], 0, 0, 0);
        o[d0] = __builtin_amdgcn_mfma_f32_32x32x16_bf16(pa1, SBA_PK(1), o[d0], 0, 0, 0);
        o[d0] = __builtin_amdgcn_mfma_f32_32x32x16_bf16(pa2, SBA_PK(2), o[d0], 0, 0, 0);
        o[d0] = __builtin_amdgcn_mfma_f32_32x32x16_bf16(pa3, SBA_PK(3), o[d0], 0, 0, 0);
#undef SBA_PK
    }
}

__device__ __forceinline__ void sb_item(Frame& F, int item) {
    int tid; { int t_ = threadIdx.x; asm volatile("" : "+v"(t_)); tid = t_; }
    const int lane = tid & 63, r32 = lane & 31, hi = lane >> 5; const int wid = __builtin_amdgcn_readfirstlane(tid >> 6);
    const int b = item >> 6, h = (item >> 3) & 7, qb = 7 - (item & 7), q0 = qb * 256;
    bf16* P = WSP(F, WS_PROJ) + (size_t)b * SEQ * PP;
    LAS unsigned char* lds = F.lds;
    volatile LAS unsigned* flg = (volatile LAS unsigned*)(lds + L_FLG);
    bf16x8 qr[4];
    { const bf16* Qw = P + (size_t)(q0 + 32 * wid + r32) * PP + PC_SBQ + h * 64;
#pragma unroll
      for (int d0 = 0; d0 < 4; ++d0) qr[d0] = *(const bf16x8*)(Qw + d0 * 16 + hi * 8); }
    const bf16* ksrc = P + (size_t)lane * PP + PC_SBK + h * 64 + wid * 8;
    const bf16* vsrc = P + (size_t)(16 * (wid & 3) + (lane >> 2)) * PP + PC_SBV + h * 64 + (wid >> 2) * 32 + (lane & 3) * 8;
    const int sdst = wid * 1024 + lane * 16;
    const int vb0 = (int)(unsigned)(size_t)(lds + L_V) + ((lane >> 4) & 1) * 32 + (lane & 3) * 8 + (4 * hi + ((lane & 15) >> 2)) * 64;
    const int kb0 = hi * 1024 + r32 * 16;
    int kt = (q0 + 256) / 64 - 1;
    v4u kreg = *(const v4u*)(ksrc + (size_t)kt * 64 * PP), vreg = *(const v4u*)(vsrc + (size_t)kt * 64 * PP);
    __syncthreads();
    *(LAS v4u*)(lds + L_K + sdst) = kreg; *(LAS v4u*)(lds + L_V + sdst) = vreg;
    __syncthreads();
    float R = 1.f; f32x16 o[2]; o[0] = f32x16{}; o[1] = f32x16{};
    const int tq = q0 + 32 * wid + r32, wmin = q0 + 32 * wid, wmax = wmin + 31;
    bool wdone = false; int buf = 0;
    for (;;) {
        const bool has_next = kt > 0;
        if (has_next) { kreg = *(const v4u*)(ksrc + (size_t)(kt - 1) * 64 * PP); vreg = *(const v4u*)(vsrc + (size_t)(kt - 1) * 64 * PP); }
        if (!wdone && 64 * kt < wmax) {
            const LAS unsigned char* Kb = lds + buf * L_BUF + L_K + kb0;
            f32x16 p0, p1;
#pragma unroll
            for (int d0 = 0; d0 < 4; ++d0) {
                const bf16x8 a0 = *(const LAS bf16x8*)(Kb + d0 * 2048), a1 = *(const LAS bf16x8*)(Kb + d0 * 2048 + 512);
                if (d0 == 0) { p0 = __builtin_amdgcn_mfma_f32_32x32x16_bf16(a0, qr[0], f32x16{}, 0, 0, 0); p1 = __builtin_amdgcn_mfma_f32_32x32x16_bf16(a1, qr[0], f32x16{}, 0, 0, 0); }
                else { p0 = __builtin_amdgcn_mfma_f32_32x32x16_bf16(a0, qr[d0], p0, 0, 0, 0); p1 = __builtin_amdgcn_mfma_f32_32x32x16_bf16(a1, qr[d0], p1, 0, 0, 0); } }
            f32x16 m0, m1;
            const bool need_mask = (64 * kt + 63 >= wmin);
#pragma unroll
            for (int r = 0; r < 16; ++r) {
                { const float e = __builtin_amdgcn_exp2f(fminf(p0[r], 100.f)); float om = __builtin_amdgcn_rcpf(1.f + e); float be = e * om;
                  if (need_mask && (64 * kt + crow(r, hi) >= tq)) { om = 1.f; be = 0.f; } m0[r] = om; p0[r] = be; }
                { const float e = __builtin_amdgcn_exp2f(fminf(p1[r], 100.f)); float om = __builtin_amdgcn_rcpf(1.f + e); float be = e * om;
                  if (need_mask && (64 * kt + 32 + crow(r, hi) >= tq)) { om = 1.f; be = 0.f; } m1[r] = om; p1[r] = be; }
            }
            float totE[8], totO[8];
#pragma unroll
            for (int g = 0; g < 4; ++g) {
                { const float t3 = m0[4 * g + 3], t2 = m0[4 * g + 2], t1 = m0[4 * g + 1], t0 = m0[4 * g]; const float s1 = t3 * t2, s0 = s1 * t1, tot = s0 * t0;
                  m0[4 * g + 2] = t3; m0[4 * g + 1] = s1; m0[4 * g] = s0;
                  auto rr = __builtin_amdgcn_permlane32_swap(__float_as_uint(tot), __float_as_uint(tot), false, false); totE[g] = __uint_as_float(rr[0]); totO[g] = __uint_as_float(rr[1]); }
                { const float t3 = m1[4 * g + 3], t2 = m1[4 * g + 2], t1 = m1[4 * g + 1], t0 = m1[4 * g]; const float s1 = t3 * t2, s0 = s1 * t1, tot = s0 * t0;
                  m1[4 * g + 2] = t3; m1[4 * g + 1] = s1; m1[4 * g] = s0;
                  auto rr = __builtin_amdgcn_permlane32_swap(__float_as_uint(tot), __float_as_uint(tot), false, false); totE[4 + g] = __uint_as_float(rr[0]); totO[4 + g] = __uint_as_float(rr[1]); }
            }
            float pref = R;
#pragma unroll
            for (int g = 7; g >= 0; --g) {
                const float sufO = pref; pref *= totO[g]; const float sufE = pref; pref *= totE[g];
                const float suf = hi ? sufO : sufE;
                if (g >= 4) { const int gg = g - 4; p1[4 * gg + 3] *= suf; p1[4 * gg + 2] *= m1[4 * gg + 2] * suf; p1[4 * gg + 1] *= m1[4 * gg + 1] * suf; p1[4 * gg] *= m1[4 * gg] * suf; }
                else { p0[4 * g + 3] *= suf; p0[4 * g + 2] *= m0[4 * g + 2] * suf; p0[4 * g + 1] *= m0[4 * g + 1] * suf; p0[4 * g] *= m0[4 * g] * suf; }
            }
            R = pref;
            v4u pw0, pw1, pw2, pw3;
            pw0 = (v4u){cvtpk(p0[0], p0[1]), cvtpk(p0[2], p0[3]), cvtpk(p0[4], p0[5]), cvtpk(p0[6], p0[7])};
            pw1 = (v4u){cvtpk(p0[8], p0[9]), cvtpk(p0[10], p0[11]), cvtpk(p0[12], p0[13]), cvtpk(p0[14], p0[15])};
            pw2 = (v4u){cvtpk(p1[0], p1[1]), cvtpk(p1[2], p1[3]), cvtpk(p1[4], p1[5]), cvtpk(p1[6], p1[7])};
            pw3 = (v4u){cvtpk(p1[8], p1[9]), cvtpk(p1[10], p1[11]), cvtpk(p1[12], p1[13]), cvtpk(p1[14], p1[15])};
            __builtin_amdgcn_sched_barrier(0);
            pv(o, vb0 + buf * L_BUF, __builtin_bit_cast(bf16x8, pw0), __builtin_bit_cast(bf16x8, pw1), __builtin_bit_cast(bf16x8, pw2), __builtin_bit_cast(bf16x8, pw3));
            wdone = __all(R < R_STOP);
        }
        if (lane == 0) flg[(kt & 1) * 8 + wid] = wdone ? 1u : 0u;
        if (has_next) { *(LAS v4u*)(lds + (buf ^ 1) * L_BUF + L_K + sdst) = kreg; *(LAS v4u*)(lds + (buf ^ 1) * L_BUF + L_V + sdst) = vreg; }
        __syncthreads();
        unsigned alld = 1u;
#pragma unroll
        for (int w = 0; w < 8; ++w) alld &= flg[(kt & 1) * 8 + w];
        if (alld || !has_next) break;
        --kt; buf ^= 1;
    }
    LAS float* stg = (LAS float*)(lds + L_STG + wid * 8704);
#pragma unroll
    for (int r = 0; r < 16; ++r) { const int orow = crow(r, hi); stg[orow * 68 + r32] = o[0][r]; stg[orow * 68 + 32 + r32] = o[1][r]; }
    asm volatile("s_waitcnt lgkmcnt(0)" ::: "memory");
    bf16* Zw = P + (size_t)(q0 + 32 * wid) * PP + PC_SBZ + h * 64;
#pragma unroll
    for (int i = 0; i < 4; ++i) { const int row = i * 8 + (lane >> 3), ch = lane & 7;
        const f32x4 a = *(const LAS f32x4*)(stg + row * 68 + ch * 8), c = *(const LAS f32x4*)(stg + row * 68 + ch * 8 + 4);
        v4u* zp = (v4u*)(Zw + (size_t)row * PP + ch * 8); const v4u z = *zp; v4u y;
        y.x = pk2(a[0] * siluf(bflo(z.x)), a[1] * siluf(bfhi(z.x))); y.y = pk2(a[2] * siluf(bflo(z.y)), a[3] * siluf(bfhi(z.y)));
        y.z = pk2(c[0] * siluf(bflo(z.z)), c[1] * siluf(bfhi(z.z))); y.w = pk2(c[2] * siluf(bflo(z.w)), c[3] * siluf(bfhi(z.w)));
        *zp = y; }
}
}
namespace ssd {
typedef short bf16x8 __attribute__((ext_vector_type(8)));
typedef short s16x4 __attribute__((ext_vector_type(4)));
typedef float f32x16 __attribute__((ext_vector_type(16)));
typedef float f32x2_t __attribute__((ext_vector_type(2)));
typedef __bf16 bf16x2_t __attribute__((ext_vector_type(2)));
__device__ __forceinline__ unsigned cvtpk(float lo, float hi) { f32x2_t v = {lo, hi}; bf16x2_t b = __builtin_convertvector(v, bf16x2_t); return __builtin_bit_cast(unsigned, b); }
__device__ __forceinline__ int crow(int r, int hi) { return (r & 3) + 8 * (r >> 2) + 4 * hi; }
constexpr int PC_ = 272  , PT_ = 144  , PY_ = 272  ;
constexpr int O_CRM = 0, O_BRM = O_CRM + 64 * PC_, O_XST = O_BRM + 64 * PC_  , O_XT = O_XST + 64 * PT_  , O_HBF = O_XT + 64 * PT_,
              O_YB = O_HBF + 64 * PC_, O_L = O_YB + 64 * PY_  , O_SC = O_L + 64 * PT_  , O_CW = O_SC + 1024  , O_END = O_CW + 5 * 320 * 4;
static_assert(O_END <= 131072, "ssd lds");

__device__ __forceinline__ void conv8(const v4u (&raw)[4], const LAS float* cwp, float (&out)[8]) {
    const f32x4 b0 = *(const LAS f32x4*)(cwp + 4 * 320), b1 = *(const LAS f32x4*)(cwp + 4 * 320 + 4);
    float acc[8] = {b0[0], b0[1], b0[2], b0[3], b1[0], b1[1], b1[2], b1[3]};
#pragma unroll
    for (int k = 0; k < 4; ++k) { const f32x4 w0 = *(const LAS f32x4*)(cwp + k * 320), w1 = *(const LAS f32x4*)(cwp + k * 320 + 4); const v4u r = raw[k];
        acc[0] += w0[0] * bflo(r.x); acc[1] += w0[1] * bfhi(r.x); acc[2] += w0[2] * bflo(r.y); acc[3] += w0[3] * bfhi(r.y);
        acc[4] += w1[0] * bflo(r.z); acc[5] += w1[1] * bfhi(r.z); acc[6] += w1[2] * bflo(r.w); acc[7] += w1[3] * bfhi(r.w); }
#pragma unroll
    for (int i = 0; i < 8; ++i) out[i] = acc[i] * __builtin_amdgcn_rcpf(1.f + __builtin_amdgcn_exp2f(-1.4426950408889634f * acc[i]));
}

__device__ __forceinline__ void ssd_item(Frame& F, const Args& args, int item, int layer) {
    int tid; { int t_ = threadIdx.x; asm volatile("" : "+v"(t_)); tid = t_; }
    const int lane = tid & 63, r32 = lane & 31, hi = lane >> 5; const int wid = __builtin_amdgcn_readfirstlane(tid >> 6);
    const int b = item >> 4, head = item & 15, g = head >> 3;
    bf16* P = WSP(F, WS_PROJ) + (size_t)b * SEQ * PP;
    float* ssqg = (float*)(F.ctl + CW_SSQG) + ((size_t)layer * T + (size_t)b * SEQ) * 2 + g;
    LAS unsigned char* lds = F.lds;
    LAS float* sc = (LAS float*)(lds + O_SC);
    LAS float* cwl = (LAS float*)(lds + O_CW);
    const float A = -expf(argp(args, I_ALOG)[layer * 16 + head]), Dk = argp(args, I_SSDD)[layer * 16 + head], dtb = argp(args, I_DTB)[layer * 16 + head];
    __syncthreads();
    { const float* cw = argp(args, I_CONVW) + layer * 4 * 1536; const float* cb = argp(args, I_CONVB) + layer * 1536;
      for (int e = tid; e < 5 * 320; e += 512) { const int k = e / 320, c = e % 320; const int ch = c < 64 ? head * 64 + c : (c < 192 ? 1024 + g * 128 + (c - 64) : 1280 + g * 128 + (c - 192));
          cwl[e] = k < 4 ? cw[k * 1536 + ch] : cb[ch]; }
      for (int e = tid; e < (64 * PC_ + 64 * PY_ + 64 * PT_) / 4; e += 512) ((LAS unsigned*)(lds + O_HBF))[e] = 0u; }
    const int xtok = tid >> 3, xcg = tid & 7;
    const bf16* xsrc = P + (size_t)xtok * PP + PC_XBC + head * 64 + xcg * 8;
    bf16* zsrc = P + (size_t)xtok * PP + PC_SSDZ + head * 64 + xcg * 8;
    const bf16* dsrc = P + (size_t)lane * PP + PC_DT + head;
    const int bctok0 = tid >> 5, bccg = tid & 31;
    const bf16* bcsrc = P + (size_t)bctok0 * PP + PC_XBC + 1024 + (bccg >> 4) * 256 + g * 128 + (bccg & 15) * 8;
    const bf16* halo_x = WSP(F, WS_HALO) + head * 64 + xcg * 8;
    const bf16* halo_bc = WSP(F, WS_HALO) + 1024 + (bccg >> 4) * 256 + g * 128 + (bccg & 15) * 8;
    const int cgl0 = b * 32;
    v4u xm, bcm[4], xt[3], bct[3], zr; unsigned short dtr;
#define SSD_TAPS(dst, tok, src, hsrc, c) do { _Pragma("unroll") for (int k = 0; k < 3; ++k) { const int idx = (tok) - 3 + k; \
        dst[k] = idx >= 0 ? *(const v4u*)((src) + (size_t)(c) * 64 * PP + (ptrdiff_t)(idx - (tok)) * PP) : ((c) > 0 ? *(const v4u*)((hsrc) + ((size_t)(cgl0 + (c) - 1) * 3 + (3 + idx)) * 1536) : (v4u){0u, 0u, 0u, 0u}); } } while (0)
#define SSD_LOAD(c) do { const size_t ro = (size_t)(c) * 64 * PP; xm = *(const v4u*)(xsrc + ro); \
        _Pragma("unroll") for (int j = 0; j < 4; ++j) bcm[j] = *(const v4u*)(bcsrc + ro + (size_t)(16 * j) * PP); \
        if (xtok < 3) SSD_TAPS(xt, xtok, xsrc, halo_x, c); if (bctok0 < 3) SSD_TAPS(bct, bctok0, bcsrc, halo_bc, c); \
        zr = *(const v4u*)(zsrc + ro); dtr = dsrc[ro]; } while (0)
    SSD_LOAD(0);
    f32x16 hacc = f32x16{};
    const int nt_ = wid >> 1, pt_ = wid & 1;
    __syncthreads();
    unsigned pacc0 = 0, pacc1 = 0, pacc2 = 0;
#pragma unroll 1
    for (int c = 0; c < 32; ++c) {
        const unsigned pt0 = MK_PROBE ? (unsigned)__builtin_amdgcn_s_memrealtime() : 0u;
        float dtv, acs, wv, dc;
        { dtv = softplusf(bf2f(dtr) + dtb); const float a = A * dtv; float s = a;
          s = wave_scan(s);
          acs = s; const float tot = __shfl(s, 63); wv = __expf(tot - acs) * dtv; dc = __expf(tot);
          if (wid == 0) { sc[lane] = acs; sc[64 + lane] = dtv; sc[128 + lane] = __expf(acs); } }
        float xv[8];
        { if (xtok < 3) { const v4u raw[4] = {xt[0], xt[1], xt[2], xm}; conv8(raw, cwl + xcg * 8, xv); }
          else { xv[0] = bflo(xm.x); xv[1] = bfhi(xm.x); xv[2] = bflo(xm.y); xv[3] = bfhi(xm.y); xv[4] = bflo(xm.z); xv[5] = bfhi(xm.z); xv[6] = bflo(xm.w); xv[7] = bfhi(xm.w); }
          const float wt = __shfl(wv, xtok);
          *(LAS v4u*)(lds + O_XT + xtok * PT_ + xcg * 16) = (v4u){cvtpk(xv[0], xv[1]), cvtpk(xv[2], xv[3]), cvtpk(xv[4], xv[5]), cvtpk(xv[6], xv[7])};
          *(LAS v4u*)(lds + O_XST + xtok * PT_ + xcg * 16) = (v4u){cvtpk(xv[0] * wt, xv[1] * wt), cvtpk(xv[2] * wt, xv[3] * wt), cvtpk(xv[4] * wt, xv[5] * wt), cvtpk(xv[6] * wt, xv[7] * wt)}; }
#pragma unroll
        for (int j = 0; j < 4; ++j) { const int tok = bctok0 + 16 * j; const int n0 = (bccg & 15) * 8; v4u pk = bcm[j];
            if (j == 0 && bctok0 < 3) { float v[8]; const v4u raw[4] = {bct[0], bct[1], bct[2], bcm[0]}; conv8(raw, cwl + 64 + (bccg >> 4) * 128 + n0, v);
                pk.x = cvtpk(v[0], v[1]); pk.y = cvtpk(v[2], v[3]); pk.z = cvtpk(v[4], v[5]); pk.w = cvtpk(v[6], v[7]); }
            *(LAS v4u*)(lds + (bccg < 16 ? O_BRM : O_CRM) + tok * PC_ + n0 * 2) = pk; }
        const v4u zcur = zr;
        __syncthreads();
        const unsigned pt1 = MK_PROBE ? (unsigned)__builtin_amdgcn_s_memrealtime() : 0u;
        if (c + 1 < 32) SSD_LOAD(c + 1);
        if (wid < 3) {
            const int mt = wid >> 1, lt = (wid + 1) >> 1;
            f32x16 gacc = f32x16{};
#pragma unroll
            for (int s = 0; s < 8; ++s) { const bf16x8 a = *(const LAS bf16x8*)(lds + O_BRM + (32 * mt + r32) * PC_ + (16 * s + 8 * hi) * 2), bb = *(const LAS bf16x8*)(lds + O_CRM + (32 * lt + r32) * PC_ + (16 * s + 8 * hi) * 2);
                gacc = __builtin_amdgcn_mfma_f32_32x32x16_bf16(a, bb, gacc, 0, 0, 0); }
            const float acs_l = sc[32 * lt + r32]; const int lcol = 32 * lt + r32;
#pragma unroll
            for (int gq = 0; gq < 4; ++gq) { const int mb = 32 * mt + 8 * gq + 4 * hi; const f32x4 am = *(const LAS f32x4*)(sc + mb), dm = *(const LAS f32x4*)(sc + 64 + mb); float v[4];
#pragma unroll
                for (int i = 0; i < 4; ++i) { const float t = gacc[4 * gq + i] * __expf(fminf(acs_l - am[i], 0.f)) * dm[i]; v[i] = (mb + i <= lcol) ? t : 0.f; }
                *(LAS v2u*)(lds + O_L + lcol * PT_ + mb * 2) = (v2u){cvtpk(v[0], v[1]), cvtpk(v[2], v[3])}; }
        }
        hacc = hacc * dc;
#pragma unroll
        for (int s = 0; s < 4; ++s) { const bf16x8 a = tr_frag(lds + O_BRM, PC_, 16 * s + 8 * hi, 32 * nt_, lane), bb = tr_frag(lds + O_XST, PT_, 16 * s + 8 * hi, 32 * pt_, lane);
            hacc = __builtin_amdgcn_mfma_f32_32x32x16_bf16(a, bb, hacc, 0, 0, 0); }
        __syncthreads();
        if (wid < 4) {
            const int lt = wid >> 1, pt = wid & 1;
            f32x16 yd = f32x16{}, yo = f32x16{};
#pragma unroll
            for (int s = 0; s < 4; ++s) if (s < 2 || lt) { const bf16x8 a = *(const LAS bf16x8*)(lds + O_L + (32 * lt + r32) * PT_ + (16 * s + 8 * hi) * 2), bb = tr_frag(lds + O_XT, PT_, 16 * s + 8 * hi, 32 * pt, lane);
                yd = __builtin_amdgcn_mfma_f32_32x32x16_bf16(a, bb, yd, 0, 0, 0); }
#pragma unroll
            for (int s = 0; s < 8; ++s) { const bf16x8 a = *(const LAS bf16x8*)(lds + O_CRM + (32 * lt + r32) * PC_ + (16 * s + 8 * hi) * 2), bb = *(const LAS bf16x8*)(lds + O_HBF + (32 * pt + r32) * PC_ + (16 * s + 8 * hi) * 2);
                yo = __builtin_amdgcn_mfma_f32_32x32x16_bf16(a, bb, yo, 0, 0, 0); }
#pragma unroll
            for (int gq = 0; gq < 4; ++gq) { const int lb = 32 * lt + 8 * gq + 4 * hi; const f32x4 el = *(const LAS f32x4*)(sc + 128 + lb);
#pragma unroll
                for (int i = 0; i < 4; ++i) *((LAS float*)(lds + O_YB + (lb + i) * PY_) + 32 * pt + r32) = yd[4 * gq + i] + yo[4 * gq + i] * el[i]; }
        }
        __syncthreads();
        const unsigned pt2 = MK_PROBE ? (unsigned)__builtin_amdgcn_s_memrealtime() : 0u;
        { LAS float* yb = (LAS float*)(lds + O_YB + xtok * PY_) + xcg * 8; const f32x4 y0 = *(const LAS f32x4*)yb, y1 = *(const LAS f32x4*)(yb + 4);
          float yg[8];
          yg[0] = (y0[0] + Dk * xv[0]) * siluf(bflo(zcur.x)); yg[1] = (y0[1] + Dk * xv[1]) * siluf(bfhi(zcur.x)); yg[2] = (y0[2] + Dk * xv[2]) * siluf(bflo(zcur.y)); yg[3] = (y0[3] + Dk * xv[3]) * siluf(bfhi(zcur.y));
          yg[4] = (y1[0] + Dk * xv[4]) * siluf(bflo(zcur.z)); yg[5] = (y1[1] + Dk * xv[5]) * siluf(bfhi(zcur.z)); yg[6] = (y1[2] + Dk * xv[6]) * siluf(bflo(zcur.w)); yg[7] = (y1[3] + Dk * xv[7]) * siluf(bfhi(zcur.w));
          float s = 0.f;
#pragma unroll
          for (int i = 0; i < 8; ++i) s += yg[i] * yg[i];
          s += __shfl_xor(s, 1); s += __shfl_xor(s, 2); s += __shfl_xor(s, 4);
          if (xcg == 0) atomicAdd(ssqg + (size_t)(c * 64 + xtok) * 2, s);
          v4u o; o.x = cvtpk(yg[0], yg[1]); o.y = cvtpk(yg[2], yg[3]); o.z = cvtpk(yg[4], yg[5]); o.w = cvtpk(yg[6], yg[7]);
          *(v4u*)(zsrc + (size_t)c * 64 * PP) = o; }
#pragma unroll
        for (int gq = 0; gq < 4; ++gq) { v2u w; w.x = cvtpk(hacc[4 * gq], hacc[4 * gq + 1]); w.y = cvtpk(hacc[4 * gq + 2], hacc[4 * gq + 3]);
            *(LAS v2u*)(lds + O_HBF + (32 * pt_ + r32) * PC_ + (32 * nt_ + 8 * gq + 4 * hi) * 2) = w; }
        __syncthreads();
        if (MK_PROBE) { const unsigned pt3 = (unsigned)__builtin_amdgcn_s_memrealtime(); pacc0 += pt1 - pt0; pacc1 += pt2 - pt1; pacc2 += pt3 - pt2; }
    }
    if (MK_PROBE && item == 0 && layer == 0 && tid == 0) { unsigned* ts = (unsigned*)(F.ctl + CW_TS); ts[48] = pacc0; ts[49] = pacc1; ts[50] = pacc2; ts[51] = 0u; }
#undef SSD_LOAD
#undef SSD_TAPS
}
}
namespace gla {
typedef short bf16x8 __attribute__((ext_vector_type(8)));
typedef float f32x16 __attribute__((ext_vector_type(16)));
typedef float f32x2_t __attribute__((ext_vector_type(2)));
typedef __bf16 bf16x2_t __attribute__((ext_vector_type(2)));
__device__ __forceinline__ unsigned cvtpk(float lo, float hi) { f32x2_t v = {lo, hi}; bf16x2_t b = __builtin_convertvector(v, bf16x2_t); return __builtin_bit_cast(unsigned, b); }
__device__ __forceinline__ int crow(int r, int hi) { return (r & 3) + 8 * (r >> 2) + 4 * hi; }
constexpr int PT_ = 144;
constexpr int PO_ = 528;
constexpr int PV_ = 272;
constexpr int O_QT = 0, O_KRM = O_QT + 64 * PT_, O_VT = O_KRM + 64 * PT_  , O_ST = O_VT + 64 * PV_, O_OB = O_ST + 128 * PT_, O_AT = O_OB + 64 * PO_  ,
              O_EG = O_AT + 64 * PT_  , O_GW = O_EG + 256  , O_GB = O_GW + 4096  , O_NW = O_GB + 256  , O_END = O_NW + 512;
static_assert(O_END <= 131072, "gla lds");


__device__ __forceinline__ void gla_prepass(Frame& F, const Args& args, int grp, int layer) {
    int tid; { int t_ = threadIdx.x; asm volatile("" : "+v"(t_)); tid = t_; }
    const int lane = tid & 63; const int wid = __builtin_amdgcn_readfirstlane(tid >> 6);
    const int b = grp >> 5, h = (grp >> 3) & 3, c0 = (grp & 7) * 4, kd0 = 8 * wid;
    bf16* P = WSP(F, WS_PROJ) + (size_t)b * SEQ * PP;
    float* EG = (float*)(F.ws + WS_EG) + ((size_t)(b * 4 + h) * 32) * 64;
    LAS unsigned char* lds = F.lds;
    LAS float* gwl = (LAS float*)(lds + O_GW); LAS float* gbl = (LAS float*)(lds + O_GB);
    __syncthreads();
    { const float* gw = argp(args, I_GATEW) + layer * 16 * 256; const float* gb = argp(args, I_GATEB) + layer * 256;
      for (int e = tid; e < 1024; e += 512) gwl[e] = gw[(e >> 6) * 256 + h * 64 + (e & 63)];
      if (tid < 64) gbl[tid] = gb[h * 64 + tid]; }
    bf16* qp = P + (size_t)(c0 * 64 + lane) * PP + PC_GQ + h * 64 + kd0;
    bf16* kp = P + (size_t)(c0 * 64 + lane) * PP + PC_GK + h * 64 + kd0;
    const bf16* gp = P + (size_t)(c0 * 64 + lane) * PP + PC_GLR;
    v4u qr[4], kr[4], g0[4], g1[4];
#pragma unroll
    for (int j = 0; j < 4; ++j) { const size_t ro = (size_t)j * 64 * PP; qr[j] = *(const v4u*)(qp + ro); kr[j] = *(const v4u*)(kp + ro); g0[j] = *(const v4u*)(gp + ro); g1[j] = *(const v4u*)(gp + ro + 8); }
    __syncthreads();
#pragma unroll
    for (int j = 0; j < 4; ++j) {
        const unsigned gwv[8] = {g0[j].x, g0[j].y, g0[j].z, g0[j].w, g1[j].x, g1[j].y, g1[j].z, g1[j].w};
        float G[8];
        { const f32x4 b0 = *(const LAS f32x4*)(gbl + kd0), b1 = *(const LAS f32x4*)(gbl + kd0 + 4); G[0] = b0[0]; G[1] = b0[1]; G[2] = b0[2]; G[3] = b0[3]; G[4] = b1[0]; G[5] = b1[1]; G[6] = b1[2]; G[7] = b1[3]; }
#pragma unroll
        for (int r = 0; r < 16; ++r) { const float gl = (r & 1) ? bfhi(gwv[r >> 1]) : bflo(gwv[r >> 1]); const f32x4 w0 = *(const LAS f32x4*)(gwl + r * 64 + kd0), w1 = *(const LAS f32x4*)(gwl + r * 64 + kd0 + 4);
            G[0] += gl * w0[0]; G[1] += gl * w0[1]; G[2] += gl * w0[2]; G[3] += gl * w0[3]; G[4] += gl * w1[0]; G[5] += gl * w1[1]; G[6] += gl * w1[2]; G[7] += gl * w1[3]; }
#pragma unroll
        for (int i = 0; i < 8; ++i) { const float x = G[i]; const float s = (fminf(x, 0.f) - __logf(1.f + __expf(-fabsf(x)))) * (1.f / 16.f); G[i] = wave_scan(s); }
        const float qf[8] = {bflo(qr[j].x), bfhi(qr[j].x), bflo(qr[j].y), bfhi(qr[j].y), bflo(qr[j].z), bfhi(qr[j].z), bflo(qr[j].w), bfhi(qr[j].w)};
        const float kf[8] = {bflo(kr[j].x), bfhi(kr[j].x), bflo(kr[j].y), bfhi(kr[j].y), bflo(kr[j].z), bfhi(kr[j].z), bflo(kr[j].w), bfhi(kr[j].w)};
        float qt[8], kt[8];
#pragma unroll
        for (int i = 0; i < 8; ++i) { const float eg = __expf(G[i]); qt[i] = qf[i] * eg; kt[i] = kf[i] * __expf(fminf(-G[i], 80.f)); if (lane == 63) EG[(c0 + j) * 64 + kd0 + i] = eg; }
        const size_t ro = (size_t)j * 64 * PP;
        *(v4u*)(qp + ro) = (v4u){cvtpk(qt[0], qt[1]), cvtpk(qt[2], qt[3]), cvtpk(qt[4], qt[5]), cvtpk(qt[6], qt[7])};
        *(v4u*)(kp + ro) = (v4u){cvtpk(kt[0], kt[1]), cvtpk(kt[2], kt[3]), cvtpk(kt[4], kt[5]), cvtpk(kt[6], kt[7])};
    }
}

__device__ __forceinline__ void gla_item(Frame& F, const Args& args, int item, int layer) {
    int tid; { int t_ = threadIdx.x; asm volatile("" : "+v"(t_)); tid = t_; }
    const int lane = tid & 63, r32 = lane & 31, hi = lane >> 5; const int wid = __builtin_amdgcn_readfirstlane(tid >> 6);
    const int b = item >> 2, h = item & 3;
    bf16* P = WSP(F, WS_PROJ) + (size_t)b * SEQ * PP;
    LAS unsigned char* lds = F.lds;
    LAS float* egl = (LAS float*)(lds + O_EG); LAS float* gwl = (LAS float*)(lds + O_GW); LAS float* gbl = (LAS float*)(lds + O_GB); LAS float* nwl = (LAS float*)(lds + O_NW);
    __syncthreads();
    { const float* nw = argp(args, I_GLANW) + layer * 128;
      if (tid < 128) nwl[tid] = nw[tid];
      for (int e = tid; e < (128 * PT_ + 64 * PO_ + 64 * PT_) / 4; e += 512) ((LAS unsigned*)(lds + O_ST))[e] = 0u; }
    const int jtok = tid >> 3, jg = tid & 7;
    const bf16* qsrc = P + (size_t)jtok * PP + PC_GQ + h * 64 + jg * 8;
    const bf16* ksrc = P + (size_t)jtok * PP + PC_GK + h * 64 + jg * 8;
    const float* egsrc = (const float*)(F.ws + WS_EG) + ((size_t)(b * 4 + h) * 32) * 64 + (tid & 63);
    const int vtok0 = tid >> 4, vg = tid & 15;
    const bf16* vsrc = P + (size_t)vtok0 * PP + PC_GV + h * 128 + vg * 8;
    const int otok = tid >> 3, og = tid & 7;
    bf16* zsrc = P + (size_t)otok * PP + PC_GZ + h * 128 + og * 16;
    v4u qr, kr, vr[2], zr0, zr1; float egr;
#define GLA_LOAD(c) do { const size_t ro = (size_t)(c) * 64 * PP; qr = *(const v4u*)(qsrc + ro); kr = *(const v4u*)(ksrc + ro); egr = egsrc[(c) * 64]; \
        vr[0] = *(const v4u*)(vsrc + ro); vr[1] = *(const v4u*)(vsrc + ro + (size_t)32 * PP); zr0 = *(const v4u*)(zsrc + ro); zr1 = *(const v4u*)(zsrc + ro + 8); } while (0)
    GLA_LOAD(0);
    f32x16 sacc = f32x16{};
    const int kt_ = wid >> 2, vt_ = wid & 3;
    __syncthreads();
    unsigned pacc0 = 0, pacc1 = 0, pacc2 = 0;
#pragma unroll 1
    for (int c = 0; c < 32; ++c) {
        const unsigned pt0 = MK_PROBE ? (unsigned)__builtin_amdgcn_s_memrealtime() : 0u;
        *(LAS v4u*)(lds + O_QT + jtok * PT_ + jg * 16) = qr; *(LAS v4u*)(lds + O_KRM + jtok * PT_ + jg * 16) = kr;
        if (tid < 64) egl[tid] = egr;
#pragma unroll
        for (int j = 0; j < 2; ++j) *(LAS v4u*)(lds + O_VT + (vtok0 + 32 * j) * PV_ + vg * 16) = vr[j];
        const v4u zc0 = zr0, zc1 = zr1;
        __syncthreads();
        const unsigned pt1 = MK_PROBE ? (unsigned)__builtin_amdgcn_s_memrealtime() : 0u;
        if (c + 1 < 32) GLA_LOAD(c + 1);
        if (wid < 3) {
            const int st = wid >> 1, tt = (wid + 1) >> 1;
            f32x16 at = f32x16{};
#pragma unroll
            for (int s = 0; s < 4; ++s) { const bf16x8 a = *(const LAS bf16x8*)(lds + O_KRM + (32 * st + r32) * PT_ + (16 * s + 8 * hi) * 2), bb = *(const LAS bf16x8*)(lds + O_QT + (32 * tt + r32) * PT_ + (16 * s + 8 * hi) * 2);
                at = __builtin_amdgcn_mfma_f32_32x32x16_bf16(a, bb, at, 0, 0, 0); }
            if (st == tt) {
#pragma unroll
                for (int r = 0; r < 16; ++r) if (crow(r, hi) > r32) at[r] = 0.f; }
#pragma unroll
            for (int gq = 0; gq < 4; ++gq) *(LAS v2u*)(lds + O_AT + (32 * tt + r32) * PT_ + (32 * st + 8 * gq + 4 * hi) * 2) = (v2u){cvtpk(at[4 * gq], at[4 * gq + 1]), cvtpk(at[4 * gq + 2], at[4 * gq + 3])};
        }
        {
#pragma unroll
            for (int s = 0; s < 4; ++s) { const bf16x8 a = tr_frag(lds + O_KRM, PT_, 16 * s + 8 * hi, 32 * kt_, lane), bb = tr_frag(lds + O_VT, PV_, 16 * s + 8 * hi, 32 * vt_, lane);
                sacc = __builtin_amdgcn_mfma_f32_32x32x16_bf16(a, bb, sacc, 0, 0, 0); }
#pragma unroll
            for (int gq = 0; gq < 4; ++gq) { const f32x4 e = *(const LAS f32x4*)(egl + 32 * kt_ + 8 * gq + 4 * hi);
                sacc[4 * gq] *= e[0]; sacc[4 * gq + 1] *= e[1]; sacc[4 * gq + 2] *= e[2]; sacc[4 * gq + 3] *= e[3]; }
        }
        __syncthreads();
        {
            f32x16 oi = f32x16{};
#pragma unroll
            for (int s = 0; s < 4; ++s) { const bf16x8 a = *(const LAS bf16x8*)(lds + O_QT + (32 * kt_ + r32) * PT_ + (16 * s + 8 * hi) * 2), bb = *(const LAS bf16x8*)(lds + O_ST + (32 * vt_ + r32) * PT_ + (16 * s + 8 * hi) * 2);
                oi = __builtin_amdgcn_mfma_f32_32x32x16_bf16(a, bb, oi, 0, 0, 0); }
#pragma unroll
            for (int s = 0; s < 4; ++s) if (s < 2 || kt_) { const bf16x8 a = *(const LAS bf16x8*)(lds + O_AT + (32 * kt_ + r32) * PT_ + (16 * s + 8 * hi) * 2), bb = tr_frag(lds + O_VT, PV_, 16 * s + 8 * hi, 32 * vt_, lane);
                oi = __builtin_amdgcn_mfma_f32_32x32x16_bf16(a, bb, oi, 0, 0, 0); }
#pragma unroll
            for (int r = 0; r < 16; ++r) *((LAS float*)(lds + O_OB + (32 * kt_ + crow(r, hi)) * PO_) + 32 * vt_ + r32) = oi[r];
        }
        __syncthreads();
        const unsigned pt2 = MK_PROBE ? (unsigned)__builtin_amdgcn_s_memrealtime() : 0u;
        { LAS float* ob = (LAS float*)(lds + O_OB + otok * PO_) + og * 16; float o[16];
#pragma unroll
          for (int q4 = 0; q4 < 4; ++q4) { const f32x4 t4 = *(const LAS f32x4*)(ob + 4 * q4); o[4 * q4] = t4[0]; o[4 * q4 + 1] = t4[1]; o[4 * q4 + 2] = t4[2]; o[4 * q4 + 3] = t4[3]; }
          float s = 0.f;
#pragma unroll
          for (int i = 0; i < 16; ++i) s += o[i] * o[i];
          s += __shfl_xor(s, 1); s += __shfl_xor(s, 2); s += __shfl_xor(s, 4);
          const float rs = rsqrtf(s * (1.f / 128.f) + EPS);
          const unsigned zw[8] = {zc0.x, zc0.y, zc0.z, zc0.w, zc1.x, zc1.y, zc1.z, zc1.w};
          unsigned ow[8];
#pragma unroll
          for (int i = 0; i < 8; ++i) { const float y0 = o[2 * i] * rs * nwl[og * 16 + 2 * i] * siluf(bflo(zw[i])), y1 = o[2 * i + 1] * rs * nwl[og * 16 + 2 * i + 1] * siluf(bfhi(zw[i])); ow[i] = cvtpk(y0, y1); }
          bf16* dst = zsrc + (size_t)c * 64 * PP;
          *(v4u*)dst = (v4u){ow[0], ow[1], ow[2], ow[3]}; *(v4u*)(dst + 8) = (v4u){ow[4], ow[5], ow[6], ow[7]}; }
#pragma unroll
        for (int gq = 0; gq < 4; ++gq) { v2u w; w.x = cvtpk(sacc[4 * gq], sacc[4 * gq + 1]); w.y = cvtpk(sacc[4 * gq + 2], sacc[4 * gq + 3]);
            *(LAS v2u*)(lds + O_ST + (32 * vt_ + r32) * PT_ + (32 * kt_ + 8 * gq + 4 * hi) * 2) = w; }
        __syncthreads();
        if (MK_PROBE) { const unsigned pt3 = (unsigned)__builtin_amdgcn_s_memrealtime(); pacc0 += pt1 - pt0; pacc1 += pt2 - pt1; pacc2 += pt3 - pt2; }
    }
    if (MK_PROBE && item == 0 && layer == 0 && tid == 0) { unsigned* ts = (unsigned*)(F.ctl + CW_TS); ts[40] = pacc0; ts[41] = pacc1; ts[42] = pacc2; ts[43] = 0u; }
#undef GLA_LOAD
}
}
#ifndef MK_N_LAUNCHES
#define MK_N_LAUNCHES 1
#endif
constexpr int N_PHASES = 8;

__device__ __forceinline__ void p0_prologue(Frame& F, const Args& args) {
    LAS float* scr = (LAS float*)(F.lds + RING_OFF + F.wave * 16384);
    const int gw = F.vcu * NWAVES + F.wave, NGW = F.G * NWAVES;
    constexpr int NITEMS = CVT_WIN_ITEMS + CVT_WOUT_ITEMS;
    for (int it = gw; it < NITEMS; it += NGW) {
        if (it < CVT_WIN_ITEMS) cvt_win_item(argp(args, I_WIN), argp(args, I_NORMW), WSP(F, WS_WIN), scr, it, F.lane);
        else cvt_wout_item(argp(args, I_WOUT), argp(args, I_SSDNW), WSP(F, WS_WOUT), scr, it - CVT_WIN_ITEMS, F.lane);
    }
    float* ssq0 = (float*)(F.ctl + CW_SSQX);
    for (int m = gw; m < T; m += NGW) row_to_bf16(argp(args, I_X) + (size_t)m * DM, WSP(F, WS_XB) + (size_t)m * DM, ssq0 + m, F.lane);
}

#define STAMP_MAX(k) do { if (MK_PROBE && F.tid == 0) atomicMax((unsigned*)(F.ctl + CW_TS + 32 + (k)), (unsigned)__builtin_amdgcn_s_memrealtime()); } while (0)
#define QUEUE_LOOP(qword, nitems, body) for (;;) { __syncthreads(); if (F.tid == 0) F.MISC[16] = __hip_atomic_fetch_add((unsigned*)(F.ctl + (qword)), 1u, RLX_AGENT); __syncthreads(); \
        const int item = (int)F.MISC[16]; if (item >= (nitems)) break; body; }
__device__ __forceinline__ void p_mixers(Frame& F, const Args& args, int layer) {
    constexpr int N_SSD = 128, N_GLA = 32, N_SB = 512;
    const int q0 = CW_Q + 256 * layer;
    QUEUE_LOOP(q0, N_GLA, gla::gla_item(F, args, item, layer)); if (layer == 0) STAMP_MAX(0);
    QUEUE_LOOP(q0 + 64, N_SSD, ssd::ssd_item(F, args, item, layer)); if (layer == 0) STAMP_MAX(1);
    QUEUE_LOOP(q0 + 128, N_SB, sba::sb_item(F, item)); if (layer == 0) STAMP_MAX(2);
    LAS float* scr = (LAS float*)(F.lds + RING_OFF + F.wave * 16384);
    if (layer == 0) { QUEUE_LOOP(q0 + 192, CVT_WIN_ITEMS / 8, cvt_win_item(argp(args, I_WIN) + (size_t)DM * NPROJ, argp(args, I_NORMW) + DM, WSP(F, WS_WIN), scr, item * 8 + F.wave, F.lane)); }
    else { QUEUE_LOOP(q0 + 192, CVT_WOUT_ITEMS / 8, cvt_wout_item(argp(args, I_WOUT) + (size_t)DI * DM, argp(args, I_SSDNW) + 1024, WSP(F, WS_WOUT), scr, item * 8 + F.wave, F.lane)); }
}


__device__ __forceinline__ void small_unit(Frame& F, int u, const float* ssq) {
    typedef float f32x16 __attribute__((ext_vector_type(16)));
    int tid; { int t_ = threadIdx.x; asm volatile("" : "+v"(t_)); tid = t_; }
    const int lane = tid & 63, r32 = lane & 31, hi = lane >> 5; const int wid = __builtin_amdgcn_readfirstlane(tid >> 6);
    const int rh = wid & 1, kq = wid >> 1;
    const bf16* A = WSP(F, WS_XB) + (size_t)(u * 64 + rh * 32 + r32) * DM + kq * 256 + hi * 8;
    const bf16* B = WSP(F, WS_WIN) + (size_t)(NMAIN + r32) * DM + kq * 256 + hi * 8;
    f32x16 acc = f32x16{};
    bf16x8_t af[16], bfr[16];
#pragma unroll
    for (int s = 0; s < 16; ++s) { af[s] = *(const bf16x8_t*)(A + 16 * s); bfr[s] = *(const bf16x8_t*)(B + 16 * s); }
#pragma unroll
    for (int s = 0; s < 16; ++s) acc = __builtin_amdgcn_mfma_f32_32x32x16_bf16(af[s], bfr[s], acc, 0, 0, 0);
    LAS float* red = (LAS float*)(F.lds);
    __syncthreads();
#pragma unroll
    for (int r = 0; r < 16; ++r) red[(kq * 64 + rh * 32 + (r & 3) + 8 * (r >> 2) + 4 * hi) * 33 + r32] = acc[r];
    __syncthreads();
    { const int row = tid >> 3, c4 = (tid & 7) * 4; float v[4];
#pragma unroll
      for (int i = 0; i < 4; ++i) v[i] = red[(0 * 64 + row) * 33 + c4 + i] + red[(1 * 64 + row) * 33 + c4 + i] + red[(2 * 64 + row) * 33 + c4 + i] + red[(3 * 64 + row) * 33 + c4 + i];
      const int grow = u * 64 + row; const float rs = rsqrtf(ssq[grow] * (1.0f / 1024.0f) + EPS);
      v2u w; w.x = pk2(v[0] * rs, v[1] * rs); w.y = pk2(v[2] * rs, v[3] * rs);
      *(v2u*)(WSP(F, WS_PROJ) + (size_t)grow * PP + NMAIN + c4) = w; }
}

__global__ void __launch_bounds__(NWAVES * 64, 2) mk_fwd(Args args) {
    extern __shared__ __attribute__((aligned(16))) unsigned char lds[];
    Frame F;
    F.lds = (LAS unsigned char*)lds;
    F.MISC = (volatile LAS unsigned*)(F.lds + MISC_OFF);
    F.tid = threadIdx.x; F.lane = F.tid & 63; F.wave = __builtin_amdgcn_readfirstlane(F.tid >> 6);
    F.G = gridDim.x; { const int bx = blockIdx.x; F.vcu = (F.G % 8 == 0) ? (bx % 8) * (F.G / 8) + bx / 8 : bx; }
    F.ws = args.ws;
    F.ctl = (gu32*)(F.ws + WS_CTL);
    for (int u = F.tid; u < (LDS_BYTES - LDSCTL_OFF) / 4; u += NWAVES * 64) ((LAS unsigned*)(F.lds + LDSCTL_OFF))[u] = 0u;
    __syncthreads();
    XcdBarrier bar; bar.bar = (unsigned*)(F.ctl + CW_BAR); bar.x = 0; bar.st = nullptr;
    if (MK_N_LAUNCHES == 1) bar = xcd_barrier_post((unsigned*)(F.ctl + CW_BAR), F.MISC + 8);
#define GRID_BAR() do { if (MK_N_LAUNCHES == 1) xcd_barrier<false>(bar); } while (0)
    const int lo = args.ph_lo, hi = args.ph_hi;
    int n_stamp = 0;
#define STAMP() do { if (MK_PROBE && blockIdx.x == 0 && F.tid == 0) __hip_atomic_store((unsigned*)(F.ctl + CW_TS + n_stamp), (unsigned)__builtin_amdgcn_s_memrealtime(), RLX_AGENT); ++n_stamp; } while (0)
    STAMP();
#define IN(k) (lo <= (k) && (k) < hi)
    if (IN(0)) { p0_prologue(F, args); if (MK_N_LAUNCHES == 1) xcd_barrier<true>(bar); } STAMP();
#pragma unroll 1
    for (int layer = 0; layer < DEPTH; ++layer) {
        float* ssq_in = (float*)(F.ctl + CW_SSQX) + layer * T;
        float* ssq_next = ssq_in + T;
        if (IN(1 + 3 * layer)) {
            pg8::Gemm g{WSP(F, WS_XB), WSP(F, WS_WIN), T, NMAIN, DM, DM}; pg8::StaticOrder S; S.init(T, NMAIN, F.G, (int)blockIdx.x);
            pg8::EpiProj E{WSP(F, WS_PROJ), PP, ssq_in, argp(args, I_CONVW) + layer * 4 * 1536, argp(args, I_CONVB) + layer * 1536, WSP(F, WS_HALO)};
            pg8::gemm_phase<pg8::EpiProj, true, false, DM, DM>(F.lds + RING_OFF, g, S, E, nullptr);
            for (int u = blockIdx.x; u < T / 64; u += F.G) small_unit(F, u, ssq_in);
            GRID_BAR();
        } STAMP();
        if (IN(2 + 3 * layer)) { for (int grp = blockIdx.x; grp < 256; grp += F.G) gla::gla_prepass(F, args, grp, layer); GRID_BAR(); p_mixers(F, args, layer); GRID_BAR(); } STAMP();
        if (IN(3 + 3 * layer)) {
            pg8::Gemm g{WSP(F, WS_PROJ) + PC_Y, WSP(F, WS_WOUT), T, DM, DI, PP}; pg8::StaticOrder S; S.init(T, DM, F.G, (int)blockIdx.x);
            LAS float* hsc = (LAS float*)(F.lds + HSC_OFF);
            { pg8::Unit u; if (S.next(0, u) && F.tid < 256) { const float* sg = (const float*)(F.ctl + CW_SSQG) + ((size_t)layer * T + (size_t)u.pm * 256 + F.tid) * 2;
                  const float r0 = rsqrtf(sg[0] * (1.f / 512.f) + EPS), r1 = rsqrtf(sg[1] * (1.f / 512.f) + EPS); hsc[F.tid * 2 + 0] = r0 / r1; hsc[F.tid * 2 + 1] = r1; } }
            VM_WAIT(); __syncthreads();
            pg8::EpiOut E{layer == 0 ? argp(args, I_X) : args.out, args.out, WSP(F, WS_XB), ssq_next, layer == 0 ? 1 : 0};
            pg8::gemm_phase<pg8::EpiOut, false, true, DI, PP>(F.lds + RING_OFF, g, S, E, hsc);
            GRID_BAR();
        } STAMP();
    }
    if (IN(7)) {
        const float* ssq2 = (const float*)(F.ctl + CW_SSQX) + 2 * T;
        const int gw = F.vcu * NWAVES + F.wave, NGW = F.G * NWAVES;
        float pscale = 1.f;
#if MK_PROBE
        { const unsigned* ts = (const unsigned*)(F.ctl + CW_TS); const int a = MK_PROBE_A, b = MK_PROBE_B;
          const float us = (float)(__hip_atomic_load(ts + a, RLX_AGENT) - __hip_atomic_load(ts + b, RLX_AGENT)) * 0.01f; pscale = 1.f + sqrtf(us * 1e-5f); }
#endif
        for (int m = gw; m < T; m += NGW) {
            const float rs = pscale * rsqrtf(ssq2[m] * (1.f / 1024.f) + EPS);
            GAS f32x4* xr = (GAS f32x4*)(args.out + (size_t)m * DM) + F.lane; const GAS f32x4* wr_ = (const GAS f32x4*)argp(args, I_FINW) + F.lane;
#pragma unroll
            for (int j = 0; j < 4; ++j) { f32x4 v = xr[64 * j]; const f32x4 w = wr_[64 * j]; v = v * rs * w; xr[64 * j] = v; }
        }
    }
#undef IN
#undef GRID_BAR
}

extern "C" void kernel_launch(void* const* d_in, const int* in_sizes, int n_in, void* d_out, int out_size, void* d_ws, size_t ws_size, hipStream_t stream) {
    static int grid = 0;
    if (grid == 0) {
        if (n_in != 14 || in_sizes[0] != T * DM || out_size != T * DM || ws_size < WS_END) { fprintf(stderr, "kernel_launch: unexpected shapes (n_in %d in0 %d out %d ws %zu)\n", n_in, n_in > 0 ? in_sizes[0] : -1, out_size, ws_size); grid = -1; return; }
        int dev = 0, cus = 0, per_cu = 0;
        if (hipGetDevice(&dev) != hipSuccess || hipDeviceGetAttribute(&cus, hipDeviceAttributeMultiprocessorCount, dev) != hipSuccess) { grid = -1; return; }
        if (hipFuncSetAttribute((const void*)mk_fwd, hipFuncAttributeMaxDynamicSharedMemorySize, LDS_BYTES) != hipSuccess) { fprintf(stderr, "kernel_launch: hipFuncSetAttribute failed\n"); grid = -1; return; }
        if (hipOccupancyMaxActiveBlocksPerMultiprocessor(&per_cu, (const void*)mk_fwd, NWAVES * 64, LDS_BYTES) != hipSuccess || per_cu < 1) { fprintf(stderr, "kernel_launch: occupancy query says %d blocks/CU\n", per_cu); }
        (void)hipGetLastError();
        grid = cus;
        if (grid != 256) fprintf(stderr, "kernel_launch: %d CUs (expected 256)\n", grid);
    }
    if (grid < 0) return;
    (void)hipMemsetAsync((char*)d_ws + WS_CTL, 0, CTL_ZERO_BYTES, stream);
    Args a{};
    for (int i = 0; i < 14; ++i) a.in[i] = (const float*)d_in[i];
    a.out = (float*)d_out; a.ws = (unsigned char*)d_ws;
    if (MK_N_LAUNCHES == 1) { a.ph_lo = 0; a.ph_hi = N_PHASES; hipLaunchKernelGGL(mk_fwd, dim3(grid), dim3(NWAVES * 64), LDS_BYTES, stream, a); }
    else for (int p = 0; p < N_PHASES; ++p) { a.ph_lo = p; a.ph_hi = p + 1; hipLaunchKernelGGL(mk_fwd, dim3(grid), dim3(NWAVES * 64), LDS_BYTES, stream, a); }
}
```

```cpp
#include <hip/hip_runtime.h>
#include <cstdio>
#include <cstdint>
namespace pg8 {
#define PG8_LAS __attribute__((address_space(3)))
typedef unsigned short bf16_t;
typedef short bf16x8 __attribute__((ext_vector_type(8)));
typedef float f32x4 __attribute__((ext_vector_type(4)));
typedef unsigned u32x4 __attribute__((ext_vector_type(4)));
typedef unsigned u32x2 __attribute__((ext_vector_type(2)));
constexpr int BM = 256, BK = 64, HALF = 128, HTB = HALF * BK * 2  , STAGE_BYTES = 8 * HTB, NXCD = 8, WGM = 8;

__host__ __device__ __forceinline__ int lds_byte(int r, int c) { const int st = (r >> 4) * 2 + (c >> 5), rr = r & 15, cc = c & 31, ob = rr * 64 + cc * 2; return st * 1024 + (ob ^ (((ob >> 9) & 1) << 5)); }
__host__ __device__ __forceinline__ void stage_rc(int b, int& R, int& C) { const int st = b / 1024, sb = b % 1024, swz = sb ^ (((sb >> 9) & 1) << 5); R = (st >> 1) * 16 + swz / 64; C = (st & 1) * 32 + (swz % 64) / 2; }
__host__ __device__ __forceinline__ int perm32(int rho) { const int n = rho >> 4, i = rho & 15; return 8 * (i >> 2) + 4 * n + (i & 3); }

struct Unit { int pm, pn; };
struct Gemm { const bf16_t* A; const bf16_t* Bt; int M, N, K, lda; };

struct StaticOrder {
    int nM, nN, nwg, G, c;
    __host__ __device__ void init(int M, int N, int G_, int c_) { nM = M / BM; nN = N / BM; nwg = nM * nN; G = G_; c = c_; }
    __host__ __device__ bool next(int i, Unit& u) const {
        const long L = (long)i * G + c; if (L >= nwg) return false;
        int wgid = (int)L; { const int q = nwg / NXCD, r = nwg % NXCD, xcd = wgid % NXCD, off = wgid / NXCD; wgid = (xcd < r ? xcd * (q + 1) : r * (q + 1) + (xcd - r) * q) + off; }
        const int nig = WGM * nN, gid = wgid / nig, fm = gid * WGM, gsz = (nM - fm) < WGM ? (nM - fm) : WGM;
        u.pm = fm + ((wgid % nig) % gsz); u.pn = (wgid % nig) / gsz; return true;
    }
};

__device__ __forceinline__ unsigned cvt_pk_bf16(float lo, float hi) { unsigned r; asm volatile("v_cvt_pk_bf16_f32 %0, %1, %2" : "=v"(r) : "v"(lo), "v"(hi)); return r; }

template <class Epi, bool ALIGN_EPI, bool HORNER, int K, int lda>
__device__ __forceinline__ void gemm_phase(PG8_LAS unsigned char* lds, const Gemm g, const StaticOrder& S, const Epi& E, const PG8_LAS float* hsc) {
    int tid_ = threadIdx.x; asm volatile("" : "+v"(tid_));
    const int tid = tid_, wid = __builtin_amdgcn_readfirstlane(tid >> 6), lane = tid & 63, wr = wid >> 2, wc = wid & 3, fr = lane & 15, fq = lane >> 4;
    constexpr int nt = K / BK;
    unsigned voffA[2], voffB[2];
#pragma unroll
    for (int i = 0; i < 2; ++i) { int R, C; stage_rc(tid * 16 + i * 8192, R, C); const int Rb = Epi::PERM ? ((R & ~31) + perm32(R & 31)) : R;
        voffA[i] = (unsigned)(R * lda + C) * 2u; voffB[i] = (unsigned)(Rb * K + C) * 2u; }
    constexpr size_t kstep = (size_t)(BK * 2);
    constexpr size_t hstepA = (size_t)HALF * lda * 2, hstepB = (size_t)HALF * K * 2;
    constexpr size_t tstepA = 2 * hstepA, tstepB = 2 * hstepB;
    const unsigned ldsw = (unsigned)wid * 1024u;
    const int aoff = lds_byte(wr * 64 + fr, fq * 8), boff = lds_byte(wc * 32 + fr, fq * 8);
#define PG8_SA(b, h) (((b) * 2 + (h)) * HTB)
#define PG8_SB(b, h) ((4 + (b) * 2 + (h)) * HTB)
#define PG8_STAGE(bufoff, gbase, voff) do { _Pragma("unroll") for (int _i = 0; _i < 2; ++_i) \
        __builtin_amdgcn_global_load_lds((const unsigned*)((const char*)(gbase) + (voff)[_i]), (PG8_LAS unsigned*)(lds + (bufoff) + ldsw + _i * 8192), 16, 0, 0); } while (0)
#define PG8_LDA(dst, b, h) do { _Pragma("unroll") for (int m = 0; m < 4; ++m) _Pragma("unroll") for (int k = 0; k < 2; ++k) dst[m][k] = *(const PG8_LAS bf16x8*)(lds + PG8_SA(b, h) + aoff + m * 2048 + k * 1024); } while (0)
#define PG8_LDB(dst, b, h) do { _Pragma("unroll") for (int n = 0; n < 2; ++n) _Pragma("unroll") for (int k = 0; k < 2; ++k) dst[n][k] = *(const PG8_LAS bf16x8*)(lds + PG8_SB(b, h) + boff + n * 2048 + k * 1024); } while (0)
#define PG8_MMA(ai, bj, At, Bt) do { __builtin_amdgcn_s_setprio(1); _Pragma("unroll") for (int m = 0; m < 4; ++m) _Pragma("unroll") for (int n = 0; n < 2; ++n) _Pragma("unroll") for (int k = 0; k < 2; ++k) \
        acc[ai][bj][m][n] = __builtin_amdgcn_mfma_f32_16x16x32_bf16(Bt[n][k], At[m][k], acc[ai][bj][m][n], 0, 0, 0); __builtin_amdgcn_s_setprio(0); } while (0)
#define PG8_WAIT_V(n) asm volatile("s_waitcnt vmcnt(" #n ")" ::: "memory")
#define PG8_WAIT_L(n) asm volatile("s_waitcnt lgkmcnt(" #n ")" ::: "memory")
#define PG8_BAR __builtin_amdgcn_s_barrier()
#define PG8_SCHED __builtin_amdgcn_sched_barrier(0)
    Unit cur, nxt; int ui = 0;
    if (!S.next(0, cur)) return;
    f32x4 acc[2][2][4][2];
#pragma unroll
    for (int a = 0; a < 2; ++a)
#pragma unroll
        for (int b = 0; b < 2; ++b)
#pragma unroll
            for (int m = 0; m < 4; ++m)
#pragma unroll
                for (int n = 0; n < 2; ++n) acc[a][b][m][n] = (f32x4){0.f, 0.f, 0.f, 0.f};
    bf16x8 At[4][2], B0[2][2], B1[2][2];
    const char* cA = (const char*)g.A + (size_t)cur.pm * tstepA; const char* cB = (const char*)g.Bt + (size_t)cur.pn * tstepB;
    PG8_STAGE(PG8_SB(0, 0), cB, voffB); PG8_STAGE(PG8_SB(0, 1), cB + hstepB, voffB); PG8_STAGE(PG8_SA(0, 0), cA, voffA); PG8_STAGE(PG8_SA(0, 1), cA + hstepA, voffA);
    if (wr == 1) PG8_BAR;
    PG8_WAIT_V(2); PG8_BAR;
    PG8_STAGE(PG8_SB(1, 0), cB + kstep, voffB); PG8_STAGE(PG8_SA(1, 0), cA + kstep, voffA); PG8_STAGE(PG8_SB(1, 1), cB + hstepB + kstep, voffB);
    PG8_WAIT_V(6); PG8_BAR;
    for (;;) {
        const bool has_next = S.next(ui + 1, nxt);
        const char* nA = has_next ? (const char*)g.A + (size_t)nxt.pm * tstepA : cA; const char* nB = has_next ? (const char*)g.Bt + (size_t)nxt.pn * tstepB : cB;
        for (int t = 0; t < nt; t += 2) {
            const bool last = (t == nt - 2);
            const char* a1 = cA + (size_t)(t + 1) * kstep;
            const char* a2 = last ? nA : cA + (size_t)(t + 2) * kstep; const char* b2 = last ? nB : cB + (size_t)(t + 2) * kstep;
            const char* a3 = a2 + kstep; const char* b3 = b2 + kstep;
            if constexpr (HORNER) {
                if (t == 8 || t == 16) { const int hc = (t == 8) ? 0 : 1;
#pragma unroll
                    for (int ai = 0; ai < 2; ++ai)
#pragma unroll
                        for (int m = 0; m < 4; ++m) { const float f = hsc[(ai * HALF + wr * 64 + m * 16 + fr) * 2 + hc];
#pragma unroll
                            for (int bj = 0; bj < 2; ++bj)
#pragma unroll
                                for (int n = 0; n < 2; ++n) acc[ai][bj][m][n] = acc[ai][bj][m][n] * f; }
                    PG8_WAIT_L(0); PG8_SCHED; }
            }
            PG8_LDB(B0, 0, 0); PG8_LDB(B1, 0, 1); PG8_SCHED; PG8_LDA(At, 0, 0); PG8_STAGE(PG8_SA(1, 1), a1 + hstepA, voffA);
            PG8_WAIT_V(8); PG8_WAIT_L(0); PG8_BAR; PG8_MMA(0, 0, At, B0); PG8_MMA(0, 1, At, B1); PG8_BAR; PG8_SCHED;
            PG8_LDA(At, 0, 1); PG8_STAGE(PG8_SB(0, 0), b2, voffB); PG8_STAGE(PG8_SB(0, 1), b2 + hstepB, voffB); PG8_STAGE(PG8_SA(0, 0), a2, voffA);
            PG8_WAIT_V(8); PG8_WAIT_L(0); PG8_BAR; PG8_MMA(1, 0, At, B0); PG8_MMA(1, 1, At, B1); PG8_BAR; PG8_SCHED;
            PG8_LDB(B0, 1, 0); PG8_LDB(B1, 1, 1); PG8_SCHED; PG8_LDA(At, 1, 0); PG8_STAGE(PG8_SA(0, 1), a2 + hstepA, voffA);
            PG8_WAIT_V(8); PG8_WAIT_L(0); PG8_BAR; PG8_MMA(0, 0, At, B0); PG8_MMA(0, 1, At, B1); PG8_BAR; PG8_SCHED;
            PG8_LDA(At, 1, 1); PG8_STAGE(PG8_SB(1, 0), b3, voffB); PG8_STAGE(PG8_SB(1, 1), b3 + hstepB, voffB); PG8_STAGE(PG8_SA(1, 0), a3, voffA);
            PG8_WAIT_V(8); PG8_WAIT_L(0); PG8_BAR; PG8_MMA(1, 0, At, B0); PG8_MMA(1, 1, At, B1); PG8_BAR; PG8_SCHED;
        }
        if constexpr (ALIGN_EPI) { if (wr == 0) PG8_BAR; }
        if constexpr (!Epi::AFTER_DRAIN) { E(acc, cur, wr, wc, fr, fq); }
        if (!has_next) break;
#pragma unroll
        for (int a = 0; a < 2; ++a)
#pragma unroll
            for (int b = 0; b < 2; ++b)
#pragma unroll
                for (int m = 0; m < 4; ++m)
#pragma unroll
                    for (int n = 0; n < 2; ++n) acc[a][b][m][n] = (f32x4){0.f, 0.f, 0.f, 0.f};
        cur = nxt; cA = nA; cB = nB; ++ui;
        if constexpr (ALIGN_EPI) { if (wr == 1) PG8_BAR; }
    }
    PG8_WAIT_V(0);
    if constexpr (!ALIGN_EPI) { if (wr == 0) PG8_BAR; }
    PG8_BAR;
    if constexpr (Epi::AFTER_DRAIN) { E.fused(acc, cur, wr, wc, fr, fq); }
#undef PG8_SA
#undef PG8_SB
#undef PG8_STAGE
#undef PG8_LDA
#undef PG8_LDB
#undef PG8_MMA
#undef PG8_WAIT_V
#undef PG8_WAIT_L
#undef PG8_BAR
#undef PG8_SCHED
}
}
#ifndef MK_PROBE
#define MK_PROBE 0
#endif
constexpr int NWAVES = 8;
constexpr int BATCH = 8, SEQ = 2048, T = BATCH * SEQ, DM = 1024, DEPTH = 2;
constexpr int NPROJ = 6176, PP = 6400  , DI = 2048;
constexpr float EPS = 1e-6f;
constexpr int PC_Y = 0;
constexpr int PC_SSDZ = 0, PC_SBZ = 1024, PC_GZ = 1536;
constexpr int PC_SBQ = 2048, PC_SBK = 2560, PC_SBV = 3072;
constexpr int PC_XBC = 3584  , PC_GQ = 5120, PC_GK = 5376, PC_GV = 5632, PC_DT = 6144, PC_GLR = 6160;
constexpr int NMAIN = 6144;
__host__ __device__ __forceinline__ int proj_orig_col(int n) {
    if (n < 1024) return 2048 + n;
    if (n < 1536) return 1536 + (n - 1024);
    if (n < 2048) return 5648 + (n - 1536);
    if (n < 3584) return n - 2048;
    if (n < 5120) return 3072 + (n - 3584);
    if (n < 6144) return 4624 + (n - 5120);
    if (n < 6160) return 4608 + (n - 6144);
    return n;
}
__host__ __device__ __forceinline__ int wout_src_row(int kk) { return kk < 1024 ? 512 + kk : (kk < 1536 ? kk - 1024 : kk); }

constexpr size_t MiB = 1u << 20;
constexpr size_t WS_CTL = 0, CTL_ZERO_BYTES = 1 * MiB;
constexpr size_t WS_WIN = 1 * MiB;
constexpr size_t WS_WOUT = 14 * MiB;
constexpr size_t WS_XB = 18 * MiB;
constexpr size_t WS_PROJ = 50 * MiB;
constexpr size_t WS_HALO = 250 * MiB;
constexpr size_t WS_EG = 253 * MiB;
constexpr size_t WS_END = 254 * MiB;
static_assert(WS_WIN + (size_t)PP * DM * 2 <= WS_WOUT && WS_WOUT + (size_t)DM * DI * 2 <= WS_XB && WS_XB + (size_t)T * DM * 2 <= WS_PROJ && WS_PROJ + (size_t)T * PP * 2 <= WS_END, "ws map");
constexpr int CW_TMO = 0, CW_CODE = 1;
constexpr int CW_BAR = 4096;
constexpr int CW_TS = 6144;
constexpr int CW_Q = 8192;
constexpr int CW_SSQX = 32768;
constexpr int CW_SSQG = CW_SSQX + 3 * T;
static_assert((CW_SSQG + 2 * T * 2) * 4 <= (int)CTL_ZERO_BYTES, "CTL");

constexpr int RING_OFF = 0, RING_BYTES = 131072;
constexpr int HSC_OFF = RING_BYTES;
constexpr int LDSCTL_OFF = HSC_OFF + 2048, MISC_OFF = LDSCTL_OFF + 320;
constexpr int LDS_BYTES = 147456;
static_assert(MISC_OFF + 128 <= LDS_BYTES, "LDS map");

#define GAS __attribute__((address_space(1)))
#define LAS __attribute__((address_space(3)))
typedef unsigned short bf16;
typedef unsigned v4u __attribute__((ext_vector_type(4)));
typedef unsigned v2u __attribute__((ext_vector_type(2)));
typedef float f32x4 __attribute__((ext_vector_type(4)));
typedef GAS unsigned gu32;
#define RLX_AGENT __ATOMIC_RELAXED, __HIP_MEMORY_SCOPE_AGENT
#define LDS_WAIT() asm volatile("s_waitcnt lgkmcnt(0)" ::: "memory")
#define VM_WAIT() asm volatile("s_waitcnt vmcnt(0)" ::: "memory")
__device__ __forceinline__ unsigned f2bf(float f) { unsigned u = __builtin_bit_cast(unsigned, f); return (u + 0x7fffu + ((u >> 16) & 1u)) >> 16; }
__device__ __forceinline__ unsigned pk2(float lo, float hi) { return f2bf(lo) | (f2bf(hi) << 16); }
__device__ __forceinline__ float bf2f(bf16 v) { return __builtin_bit_cast(float, (unsigned)v << 16); }
__device__ __forceinline__ float bflo(unsigned w) { return __builtin_bit_cast(float, w << 16); }
__device__ __forceinline__ float bfhi(unsigned w) { return __builtin_bit_cast(float, w & 0xffff0000u); }
__device__ __forceinline__ float siluf(float x) { return x / (1.f + __expf(-x)); }
__device__ __forceinline__ float fsilu(float x) { return x * __builtin_amdgcn_rcpf(1.f + __builtin_amdgcn_exp2f(-1.4426950408889634f * x)); }
__device__ __forceinline__ float softplusf(float x) { return fmaxf(x, 0.f) + log1pf(expf(-fabsf(x))); }
__device__ __forceinline__ float logsigf(float x) { return fminf(x, 0.f) - log1pf(expf(-fabsf(x))); }

typedef short bf16x8_t __attribute__((ext_vector_type(8)));
typedef short v4i16_t __attribute__((ext_vector_type(4)));
__device__ __forceinline__ bf16x8_t tr_frag(const LAS unsigned char* img, int pitch, int row0, int col0, int lane) {
    const LAS unsigned char* p = img + (row0 + ((lane & 15) >> 2)) * pitch + (col0 + 16 * ((lane >> 4) & 1) + 4 * (lane & 3)) * 2;
    const v4i16_t lo = __builtin_amdgcn_ds_read_tr16_b64_v4i16((LAS v4i16_t*)p), hi = __builtin_amdgcn_ds_read_tr16_b64_v4i16((LAS v4i16_t*)(p + 4 * pitch));
    return (bf16x8_t){lo[0], lo[1], lo[2], lo[3], hi[0], hi[1], hi[2], hi[3]};
}
__device__ __forceinline__ bf16x8_t tr_frag_perm(const LAS unsigned char* img, int pitch, int row0, int col0, int lane) {
    const LAS unsigned char* p = img + (row0 + 4 * (lane >> 5) + ((lane & 15) >> 2)) * pitch + (col0 + 16 * ((lane >> 4) & 1) + 4 * (lane & 3)) * 2;
    const v4i16_t lo = __builtin_amdgcn_ds_read_tr16_b64_v4i16((LAS v4i16_t*)p), hi = __builtin_amdgcn_ds_read_tr16_b64_v4i16((LAS v4i16_t*)(p + 8 * pitch));
    return (bf16x8_t){lo[0], lo[1], lo[2], lo[3], hi[0], hi[1], hi[2], hi[3]};
}
#define DPP_ADD(s, ctrl, rmask) s += __builtin_bit_cast(float, __builtin_amdgcn_update_dpp(0, __builtin_bit_cast(int, s), ctrl, rmask, 0xf, false))
__device__ __forceinline__ float wave_scan(float s) {
    DPP_ADD(s, 0x111, 0xf); DPP_ADD(s, 0x112, 0xf); DPP_ADD(s, 0x114, 0xf); DPP_ADD(s, 0x118, 0xf);
    DPP_ADD(s, 0x142, 0xa); DPP_ADD(s, 0x143, 0xc);
    return s;
}

#define XB_TMO      128
#define XB_XCNT(j)  (256  + 64 * (j))
#define XB_XSUB(j)  (1280 + 64 * (j))
#define XB_XGEN(j)  (2304 + 64 * (j))
#define XB_TOP      3328
#define XB_TOPGEN   3392
#define XCD_BAR_WORDS 3456
#define XB_SPIN_CAP (1u << 22)
__device__ __forceinline__ unsigned xb_ld(unsigned* p)              { return __hip_atomic_load(p, __ATOMIC_RELAXED, __HIP_MEMORY_SCOPE_AGENT); }
__device__ __forceinline__ unsigned xb_add(unsigned* p, unsigned v) { return __hip_atomic_fetch_add(p, v, __ATOMIC_RELAXED, __HIP_MEMORY_SCOPE_AGENT); }
__device__ __forceinline__ unsigned xb_xcc_id() { return (unsigned)__builtin_amdgcn_s_getreg((3 << 11) | 20) & 0xFu; }
#define XB_SPIN(cond, bar) do { unsigned _sp = 0; while (cond) { __builtin_amdgcn_s_sleep(1); \
    if ((++_sp & 255u) == 0u) { if (xb_ld(&(bar)[XB_TMO])) break; if (_sp > XB_SPIN_CAP) { atomicAdd(&(bar)[XB_TMO], 1u); break; } } } } while (0)
struct XcdBarrier { unsigned* bar; unsigned x; volatile LAS unsigned* st; };
__device__ __forceinline__ XcdBarrier xcd_barrier_post(unsigned* bar, volatile LAS unsigned* st) {
    XcdBarrier b; b.bar = bar; b.x = xb_xcc_id(); b.st = st;
    if (threadIdx.x == 0) (void)xb_add(&bar[XB_XCNT(b.x)], 1u);
    return b;
}
__device__ __forceinline__ void xcd_barrier_complete(unsigned* bar, unsigned x, unsigned& nloc, unsigned& nx) {
    const unsigned G = gridDim.x * gridDim.y * gridDim.z;
    unsigned sum, cnt, sp = 0u;
    for (;;) {
        sum = 0u; cnt = 0u;
#pragma unroll 1
        for (unsigned j = 0; j < 16; ++j) { const unsigned c = xb_ld(&bar[XB_XCNT(j)]); sum += c; cnt += (c > 0u) ? 1u : 0u; }
        if (sum == G) break;
        __builtin_amdgcn_s_sleep(1);
        if ((++sp & 255u) == 0u) { if (xb_ld(&bar[XB_TMO])) break; if (sp > XB_SPIN_CAP) { atomicAdd(&bar[XB_TMO], 1u); break; } }
    }
    const unsigned mine = xb_ld(&bar[XB_XCNT(x)]);
    nloc = mine > 0u ? mine : 1u; nx = cnt > 0u ? cnt : 1u;
}
template <bool FIRST> __device__ __forceinline__ void xcd_barrier(const XcdBarrier& b) {
    asm volatile("s_waitcnt vmcnt(0)" ::: "memory");
    __syncthreads();
    if (threadIdx.x == 0) {
        unsigned* bar = b.bar;
        __builtin_amdgcn_s_waitcnt(0);
        unsigned nloc = b.st[0], nx = b.st[1];
        if constexpr (FIRST) { if (nloc == 0u) { xcd_barrier_complete(bar, b.x, nloc, nx); b.st[0] = nloc; b.st[1] = nx; } }
        const unsigned old = xb_add(&bar[XB_XSUB(b.x)], 1u);
        const unsigned gen = old / nloc;
        if (old + 1u == (gen + 1u) * nloc) {
            __builtin_amdgcn_fence(__ATOMIC_RELEASE, "agent");
            asm volatile("s_waitcnt vmcnt(0)" ::: "memory");
            const unsigned og = xb_add(&bar[XB_TOP], 1u);
            const unsigned tg = og / nx;
            if (og + 1u == (tg + 1u) * nx) xb_add(&bar[XB_TOPGEN], 1u);
            else XB_SPIN(xb_ld(&bar[XB_TOPGEN]) == tg, bar);
            __builtin_amdgcn_fence(__ATOMIC_ACQUIRE, "agent");
            xb_add(&bar[XB_XGEN(b.x)], 1u);
            asm volatile("s_waitcnt vmcnt(0)" ::: "memory");
        } else {
            XB_SPIN(xb_ld(&bar[XB_XGEN(b.x)]) == gen, bar);
            __builtin_amdgcn_fence(__ATOMIC_ACQUIRE, "agent");
            asm volatile("s_waitcnt vmcnt(0)" ::: "memory");
        }
    }
    __syncthreads();
}

namespace pg8 {
#define DPP_MOV(name, ctl) __device__ __forceinline__ int name(int x) { int r; asm("s_nop 1\n\tv_mov_b32_dpp %0, %1 " ctl " row_mask:0xf bank_mask:0xf bound_ctrl:1" : "=v"(r) : "v"(x)); return r; }
__device__ __forceinline__ int dpp_src(int x) { int r; asm volatile("v_mov_b32 %0, %1" : "=v"(r) : "v"(x)); return r; }
DPP_MOV(dpp_ror1, "row_ror:1") DPP_MOV(dpp_ror2, "row_ror:2") DPP_MOV(dpp_ror3, "row_ror:3") DPP_MOV(dpp_shr1, "row_shr:1") DPP_MOV(dpp_shr2, "row_shr:2") DPP_MOV(dpp_shr3, "row_shr:3") DPP_MOV(dpp_shl15, "row_shl:15") DPP_MOV(dpp_shl14, "row_shl:14") DPP_MOV(dpp_shl13, "row_shl:13")
struct EpiProj {
    static constexpr bool PERM = true, AFTER_DRAIN = false;
    bf16_t* O; int ldc; const float* ssq; const float* cw; const float* cb; bf16_t* halo;
    __device__ __forceinline__ void operator()(f32x4 (&acc)[2][2][4][2], const Unit& u, int wr, int wc, int fr, int fq) const {
        const int row0 = u.pm * BM + wr * 64 + fr, col0 = u.pn * BM + wc * 32 + 8 * fq;
#pragma unroll
        for (int ai = 0; ai < 2; ++ai)
#pragma unroll
            for (int m = 0; m < 4; ++m) { const float rs = rsqrtf(ssq[row0 + ai * HALF + m * 16] * (1.0f / 1024.0f) + 1e-6f);
#pragma unroll
                for (int bj = 0; bj < 2; ++bj) { acc[ai][bj][m][0] = acc[ai][bj][m][0] * rs; acc[ai][bj][m][1] = acc[ai][bj][m][1] * rs; } }
        if (u.pn >= 14 && u.pn < 20) {
#pragma unroll
            for (int bj = 0; bj < 2; ++bj) {
                const int ch0 = col0 + bj * HALF - 3584;
                if (fr >= 13) {
#pragma unroll
                    for (int ai = 0; ai < 2; ++ai) { const f32x4 r0 = acc[ai][bj][3][0], r1 = acc[ai][bj][3][1];
                        u32x4 w; w.x = cvt_pk_bf16(r0[0], r0[1]); w.y = cvt_pk_bf16(r0[2], r0[3]); w.z = cvt_pk_bf16(r1[0], r1[1]); w.w = cvt_pk_bf16(r1[2], r1[3]);
                        const int blk = (u.pm * BM + ai * HALF + wr * 64) >> 6;
                        *(u32x4*)(halo + ((size_t)blk * 3 + (fr - 13)) * 1536 + ch0) = w; } }
#pragma unroll
                for (int n = 0; n < 2; ++n) {
                    asm volatile("" ::: "memory");
                    const f32x4 w0 = *(const f32x4*)(cw + 0 * 1536 + ch0 + 4 * n), w1 = *(const f32x4*)(cw + 1 * 1536 + ch0 + 4 * n), w2 = *(const f32x4*)(cw + 2 * 1536 + ch0 + 4 * n),
                                w3 = *(const f32x4*)(cw + 3 * 1536 + ch0 + 4 * n), bb = *(const f32x4*)(cb + ch0 + 4 * n);
#pragma unroll
                    for (int ai = 0; ai < 2; ++ai) {
                        float out[4][4], raw[4][4];
#pragma unroll
                        for (int m = 0; m < 4; ++m) { const f32x4 t = acc[ai][bj][m][n]; raw[m][0] = t[0]; raw[m][1] = t[1]; raw[m][2] = t[2]; raw[m][3] = t[3]; }
#pragma unroll
                        for (int e = 0; e < 4; ++e)
#pragma unroll
                            for (int m = 0; m < 4; ++m) {
                                const float vm = raw[m][e];
                                const int cur = __builtin_bit_cast(int, vm);
                                int prv = 0; if (m > 0) prv = __builtin_bit_cast(int, raw[m > 0 ? m - 1 : 0][e]);
                                const float p1 = __builtin_bit_cast(float, dpp_ror1(fr >= 15 ? prv : cur));
                                const float p2 = __builtin_bit_cast(float, dpp_ror2(fr >= 14 ? prv : cur));
                                const float p3 = __builtin_bit_cast(float, dpp_ror3(fr >= 13 ? prv : cur));
                                const float s = bb[e] + w3[e] * vm + w2[e] * p1 + w1[e] * p2 + w0[e] * p3;
                                const float y = s * __builtin_amdgcn_rcpf(1.f + __builtin_amdgcn_exp2f(-1.4426950408889634f * s));
                                out[m][e] = (m == 0 && fr < 3) ? vm : y;
                            }
#pragma unroll
                        for (int m = 0; m < 4; ++m) { u32x2 w; w.x = cvt_pk_bf16(out[m][0], out[m][1]); w.y = cvt_pk_bf16(out[m][2], out[m][3]);
                            *(u32x2*)(O + (size_t)(row0 + ai * HALF + m * 16) * ldc + col0 + bj * HALF + 4 * n) = w; }
                    }
                    __builtin_amdgcn_sched_barrier(0);
                }
            }
            return;
        }
#pragma unroll
        for (int ai = 0; ai < 2; ++ai)
#pragma unroll
            for (int m = 0; m < 4; ++m) { const int row = row0 + ai * HALF + m * 16; bf16_t* rowp = O + (size_t)row * ldc + col0;
#pragma unroll
                for (int bj = 0; bj < 2; ++bj) { const f32x4 v0 = acc[ai][bj][m][0], v1 = acc[ai][bj][m][1];
                    u32x4 w; w.x = cvt_pk_bf16(v0[0], v0[1]); w.y = cvt_pk_bf16(v0[2], v0[3]); w.z = cvt_pk_bf16(v1[0], v1[1]); w.w = cvt_pk_bf16(v1[2], v1[3]);
                    *(u32x4*)(rowp + bj * HALF) = w; } }
    }
};
struct EpiOut {
    static constexpr bool PERM = false, AFTER_DRAIN = true;
    const float* xin; float* xout; bf16_t* xb; float* ssq; int write_xb;
    __device__ __forceinline__ void fused(const f32x4 (&acc)[2][2][4][2], const Unit& u, int wr, int wc, int fr, int fq) const {
        const int col0 = u.pn * BM + wc * 32 + 4 * fq;
#pragma unroll
        for (int ai = 0; ai < 2; ++ai)
#pragma unroll
            for (int m = 0; m < 4; ++m) { const int row = u.pm * BM + ai * HALF + wr * 64 + m * 16 + fr; const size_t off = (size_t)row * 1024 + col0; float s = 0.f;
#pragma unroll
                for (int bj = 0; bj < 2; ++bj)
#pragma unroll
                    for (int n = 0; n < 2; ++n) { const f32x4 o = *(const f32x4*)(xin + off + bj * HALF + n * 16) + acc[ai][bj][m][n];
                        *(f32x4*)(xout + off + bj * HALF + n * 16) = o; s += (o[0] * o[0] + o[1] * o[1]) + (o[2] * o[2] + o[3] * o[3]);
                        if (write_xb) { u32x2 w; w.x = cvt_pk_bf16(o[0], o[1]); w.y = cvt_pk_bf16(o[2], o[3]); *(u32x2*)(xb + off + bj * HALF + n * 16) = w; } }
                s += __shfl_xor(s, 16); s += __shfl_xor(s, 32);
                if (fq == 0) atomicAdd(ssq + row, s);
                asm volatile("" ::: "memory"); }
    }
};
}

struct Frame {
    LAS unsigned char* lds;
    volatile LAS unsigned* MISC;
    gu32* ctl;
    int tid, lane, wave, vcu, G;
    unsigned char* ws;
};
struct Args { const float* in[14]; float* out; unsigned char* ws; int ph_lo, ph_hi; };
enum { I_X = 0, I_NORMW, I_WIN, I_CONVW, I_CONVB, I_DTB, I_ALOG, I_SSDD, I_SSDNW, I_GATEW, I_GATEB, I_GLANW, I_WOUT, I_FINW };
#define WSP(F, off) ((bf16*)((F).ws + (off)))
__device__ __forceinline__ const float* argp(const Args& a, int i) { asm volatile("" : "+s"(i)); return a.in[i]; }

__device__ __forceinline__ float wave_sum(float v) {
#pragma unroll
    for (int o = 1; o < 64; o <<= 1) v += __shfl_xor(v, o);
    return v;
}
__device__ __forceinline__ void cvt_win_item(const float* W, const float* nw, bf16* WT, LAS float* scr, int item, int lane) {
    const int nblk = PP / 32, kb = item / nblk, nb = item % nblk, k0 = 64 * kb, n0 = 32 * nb;
    const int r8 = lane >> 3, c4 = (lane & 7) * 4, n = n0 + c4; const bool valid = n < NPROJ; const int oc = valid ? proj_orig_col(n) : 0;
    const float cs = (n >= PC_SBQ && n < PC_SBQ + 512) ? 0.18033688011112042f : ((n >= PC_GQ && n < PC_GQ + 256) ? 0.125f : 1.f);
    f32x4 v[8];
#pragma unroll
    for (int i = 0; i < 8; ++i) v[i] = valid ? *(const f32x4*)(W + (size_t)(k0 + 8 * i + r8) * NPROJ + oc) : (f32x4){0.f, 0.f, 0.f, 0.f};
#pragma unroll
    for (int i = 0; i < 8; ++i) { const int kk = 8 * i + r8; const float sc_ = nw[k0 + kk] * cs; LAS float* d = scr + kk * 33 + c4; d[0] = v[i][0] * sc_; d[1] = v[i][1] * sc_; d[2] = v[i][2] * sc_; d[3] = v[i][3] * sc_; }
    LDS_WAIT(); asm volatile("" ::: "memory");
    const int c = lane & 7;
#pragma unroll
    for (int j = 0; j < 4; ++j) { const int nn = (lane >> 3) + 8 * j; const LAS float* s = scr + (8 * c) * 33 + nn;
        v4u o; o.x = pk2(s[0 * 33], s[1 * 33]); o.y = pk2(s[2 * 33], s[3 * 33]); o.z = pk2(s[4 * 33], s[5 * 33]); o.w = pk2(s[6 * 33], s[7 * 33]);
        *(GAS v4u*)(WT + (size_t)(n0 + nn) * DM + k0 + 8 * c) = o; }
    LDS_WAIT(); asm volatile("" ::: "memory");
}
__device__ __forceinline__ void cvt_wout_item(const float* W, const float* snw, bf16* WT, LAS float* scr, int item, int lane) {
    const int nblk = DM / 32, kb = item / nblk, nb = item % nblk, k0 = 64 * kb, n0 = 32 * nb;
    const int r8 = lane >> 3, c4 = (lane & 7) * 4;
    f32x4 v[8];
#pragma unroll
    for (int i = 0; i < 8; ++i) v[i] = *(const f32x4*)(W + (size_t)wout_src_row(k0 + 8 * i + r8) * DM + n0 + c4);
#pragma unroll
    for (int i = 0; i < 8; ++i) { const int kk = 8 * i + r8; const float sc_ = (k0 + kk) < 1024 ? snw[k0 + kk] : 1.f; LAS float* d = scr + kk * 33 + c4; d[0] = v[i][0] * sc_; d[1] = v[i][1] * sc_; d[2] = v[i][2] * sc_; d[3] = v[i][3] * sc_; }
    LDS_WAIT(); asm volatile("" ::: "memory");
    const int c = lane & 7;
#pragma unroll
    for (int j = 0; j < 4; ++j) { const int nn = (lane >> 3) + 8 * j; const LAS float* s = scr + (8 * c) * 33 + nn;
        v4u o; o.x = pk2(s[0 * 33], s[1 * 33]); o.y = pk2(s[2 * 33], s[3 * 33]); o.z = pk2(s[4 * 33], s[5 * 33]); o.w = pk2(s[6 * 33], s[7 * 33]);
        *(GAS v4u*)(WT + (size_t)(n0 + nn) * DI + k0 + 8 * c) = o; }
    LDS_WAIT(); asm volatile("" ::: "memory");
}
constexpr int CVT_WIN_ITEMS = (DM / 64) * (PP / 32);
constexpr int CVT_WOUT_ITEMS = (DI / 64) * (DM / 32);
__device__ __forceinline__ void row_to_bf16(const float* xrow, bf16* orow, float* ssq, int lane) {
    const GAS f32x4* xr = (const GAS f32x4*)xrow + lane;
    f32x4 v[4]; float s = 0.f;
#pragma unroll
    for (int j = 0; j < 4; ++j) { v[j] = xr[64 * j]; s += (v[j].x * v[j].x + v[j].y * v[j].y) + (v[j].z * v[j].z + v[j].w * v[j].w); }
    s = wave_sum(s);
    GAS unsigned long long* o8 = (GAS unsigned long long*)orow + lane;
#pragma unroll
    for (int j = 0; j < 4; ++j) o8[64 * j] = (unsigned long long)pk2(v[j].x, v[j].y) | ((unsigned long long)pk2(v[j].z, v[j].w) << 32);
    if (lane == 0) *ssq = s;
}
namespace sba {
typedef short bf16x8 __attribute__((ext_vector_type(8)));
typedef short s16x4 __attribute__((ext_vector_type(4)));
typedef float f32x16 __attribute__((ext_vector_type(16)));
typedef float f32x2_t __attribute__((ext_vector_type(2)));
typedef __bf16 bf16x2_t __attribute__((ext_vector_type(2)));
__device__ __forceinline__ unsigned cvtpk(float lo, float hi) { f32x2_t v = {lo, hi}; bf16x2_t b = __builtin_convertvector(v, bf16x2_t); return __builtin_bit_cast(unsigned, b); }
__device__ __forceinline__ int crow(int r, int hi) { return (r & 3) + 8 * (r >> 2) + 4 * hi; }
constexpr int L_K = 0, L_V = 8192, L_BUF = 16384, L_FLG = 32768, L_STG = 33792;
constexpr float R_STOP = 8.67361738e-19f;

__device__ __forceinline__ void pv(f32x16* o, int vb, bf16x8 pa0, bf16x8 pa1, bf16x8 pa2, bf16x8 pa3) {
#pragma unroll
    for (int d0 = 0; d0 < 2; ++d0) { s16x4 lo[4], hi[4];
#pragma unroll
        for (int ks = 0; ks < 4; ++ks) {
            asm volatile("ds_read_b64_tr_b16 %0,%1 offset:%c2" : "=&v"(lo[ks]) : "v"(vb), "i"(d0 * 4096 + ks * 1024) : "memory");
            asm volatile("ds_read_b64_tr_b16 %0,%1 offset:%c2" : "=&v"(hi[ks]) : "v"(vb), "i"(d0 * 4096 + ks * 1024 + 512) : "memory"); }
        asm volatile("s_waitcnt lgkmcnt(0)" ::: "memory"); __builtin_amdgcn_sched_barrier(0);
#define SBA_PK(k) (bf16x8){lo[k][0], lo[k][1], lo[k][2], lo[k][3], hi[k][0], hi[k][1], hi[k][2], hi[k][3]}
        o[d0] = __builtin_amdgcn_mfma_f32_32x32x16_bf16(pa0, SBA_PK(0), o[d0], 0, 0, 0);
        o[d0] = __builtin_amdgcn_mfma_f32_32x32x16_bf16(pa1, SBA_PK(1), o[d0], 0, 0, 0);
        o[d0] = __builtin_amdgcn_mfma_f32_32x32x16_bf16(pa2, SBA_PK(2), o[d0], 0, 0, 0);
        o[d0] = __builtin_amdgcn_mfma_f32_32x32x16_bf16(pa3, SBA_PK(3), o[d0], 0, 0, 0);
#undef SBA_PK
    }
}

__device__ __forceinline__ void sb_item(Frame& F, int item) {
    int tid; { int t_ = threadIdx.x; asm volatile("" : "+v"(t_)); tid = t_; }
    const int lane = tid & 63, r32 = lane & 31, hi = lane >> 5; const int wid = __builtin_amdgcn_readfirstlane(tid >> 6);
    const int b = item >> 6, h = (item >> 3) & 7, qb = 7 - (item & 7), q0 = qb * 256;
    bf16* P = WSP(F, WS_PROJ) + (size_t)b * SEQ * PP;
    LAS unsigned char* lds = F.lds;
    volatile LAS unsigned* flg = (volatile LAS unsigned*)(lds + L_FLG);
    bf16x8 qr[4];
    { const bf16* Qw = P + (size_t)(q0 + 32 * wid + r32) * PP + PC_SBQ + h * 64;
#pragma unroll
      for (int d0 = 0; d0 < 4; ++d0) qr[d0] = *(const bf16x8*)(Qw + d0 * 16 + hi * 8); }
    const bf16* ksrc = P + (size_t)lane * PP + PC_SBK + h * 64 + wid * 8;
    const bf16* vsrc = P + (size_t)(16 * (wid & 3) + (lane >> 2)) * PP + PC_SBV + h * 64 + (wid >> 2) * 32 + (lane & 3) * 8;
    const int sdst = wid * 1024 + lane * 16;
    const int vb0 = (int)(unsigned)(size_t)(lds + L_V) + ((lane >> 4) & 1) * 32 + (lane & 3) * 8 + (4 * hi + ((lane & 15) >> 2)) * 64;
    const int kb0 = hi * 1024 + r32 * 16;
    int kt = (q0 + 256) / 64 - 1;
    v4u kreg = *(const v4u*)(ksrc + (size_t)kt * 64 * PP), vreg = *(const v4u*)(vsrc + (size_t)kt * 64 * PP);
    __syncthreads();
    *(LAS v4u*)(lds + L_K + sdst) = kreg; *(LAS v4u*)(lds + L_V + sdst) = vreg;
    __syncthreads();
    float R = 1.f; f32x16 o[2]; o[0] = f32x16{}; o[1] = f32x16{};
    const int tq = q0 + 32 * wid + r32, wmin = q0 + 32 * wid, wmax = wmin + 31;
    bool wdone = false; int buf = 0;
    for (;;) {
        const bool has_next = kt > 0;
        if (has_next) { kreg = *(const v4u*)(ksrc + (size_t)(kt - 1) * 64 * PP); vreg = *(const v4u*)(vsrc + (size_t)(kt - 1) * 64 * PP); }
        if (!wdone && 64 * kt < wmax) {
            const LAS unsigned char* Kb = lds + buf * L_BUF + L_K + kb0;
            f32x16 p0, p1;
#pragma unroll
            for (int d0 = 0; d0 < 4; ++d0) {
                const bf16x8 a0 = *(const LAS bf16x8*)(Kb + d0 * 2048), a1 = *(const LAS bf16x8*)(Kb + d0 * 2048 + 512);
                if (d0 == 0) { p0 = __builtin_amdgcn_mfma_f32_32x32x16_bf16(a0, qr[0], f32x16{}, 0, 0, 0); p1 = __builtin_amdgcn_mfma_f32_32x32x16_bf16(a1, qr[0], f32x16{}, 0, 0, 0); }
                else { p0 = __builtin_amdgcn_mfma_f32_32x32x16_bf16(a0, qr[d0], p0, 0, 0, 0); p1 = __builtin_amdgcn_mfma_f32_32x32x16_bf16(a1, qr[d0], p1, 0, 0, 0); } }
            f32x16 m0, m1;
            const bool need_mask = (64 * kt + 63 >= wmin);
#pragma unroll
            for (int r = 0; r < 16; ++r) {
                { const float e = __builtin_amdgcn_exp2f(fminf(p0[r], 100.f)); float om = __builtin_amdgcn_rcpf(1.f + e); float be = e * om;
                  if (need_mask && (64 * kt + crow(r, hi) >= tq)) { om = 1.f; be = 0.f; } m0[r] = om; p0[r] = be; }
                { const float e = __builtin_amdgcn_exp2f(fminf(p1[r], 100.f)); float om = __builtin_amdgcn_rcpf(1.f + e); float be = e * om;
                  if (need_mask && (64 * kt + 32 + crow(r, hi) >= tq)) { om = 1.f; be = 0.f; } m1[r] = om; p1[r] = be; }
            }
            float totE[8], totO[8];
#pragma unroll
            for (int g = 0; g < 4; ++g) {
                { const float t3 = m0[4 * g + 3], t2 = m0[4 * g + 2], t1 = m0[4 * g + 1], t0 = m0[4 * g]; const float s1 = t3 * t2, s0 = s1 * t1, tot = s0 * t0;
                  m0[4 * g + 2] = t3; m0[4 * g + 1] = s1; m0[4 * g] = s0;
                  auto rr = __builtin_amdgcn_permlane32_swap(__float_as_uint(tot), __float_as_uint(tot), false, false); totE[g] = __uint_as_float(rr[0]); totO[g] = __uint_as_float(rr[1]); }
                { const float t3 = m1[4 * g + 3], t2 = m1[4 * g + 2], t1 = m1[4 * g + 1], t0 = m1[4 * g]; const float s1 = t3 * t2, s0 = s1 * t1, tot = s0 * t0;
                  m1[4 * g + 2] = t3; m1[4 * g + 1] = s1; m1[4 * g] = s0;
                  auto rr = __builtin_amdgcn_permlane32_swap(__float_as_uint(tot), __float_as_uint(tot), false, false); totE[4 + g] = __uint_as_float(rr[0]); totO[4 + g] = __uint_as_float(rr[1]); }
            }
            float pref = R;
#pragma unroll
            for (int g = 7; g >= 0; --g) {
                const float sufO = pref; pref *= totO[g]; const float sufE = pref; pref *= totE[g];
                const float suf = hi ? sufO : sufE;
                if (g >= 4) { const int gg = g - 4; p1[4 * gg + 3] *= suf; p1[4 * gg + 2] *= m1[4 * gg + 2] * suf; p1[4 * gg + 1] *= m1[4 * gg + 1] * suf; p1[4 * gg] *= m1[4 * gg] * suf; }
                else { p0[4 * g + 3] *= suf; p0[4 * g + 2] *= m0[4 * g + 2] * suf; p0[4 * g + 1] *= m0[4 * g + 1] * suf; p0[4 * g] *= m0[4 * g] * suf; }
            }
            R = pref;
            v4u pw0, pw1, pw2, pw3;
            pw0 = (v4u){cvtpk(p0[0], p0[1]), cvtpk(p0[2], p0[3]), cvtpk(p0[4], p0[5]), cvtpk(p0[6], p0[7])};
            pw1 = (v4u){cvtpk(p0[8], p0[9]), cvtpk(p0[10], p0[11]), cvtpk(p0[12], p0[13]), cvtpk(p0[14], p0[15])};
            pw2 = (v4u){cvtpk(p1[0], p1[1]), cvtpk(p1[2], p1[3]), cvtpk(p1[4], p1[5]), cvtpk(p1[6], p1[7])};
            pw3 = (v4u){cvtpk(p1[8], p1[9]), cvtpk(p1[10], p1[11]), cvtpk(p1[12], p1[13]), cvtpk(p1[14], p1[15])};
            __builtin_amdgcn_sched_barrier(0);
            pv(o, vb0 + buf * L_BUF, __builtin_bit_cast(bf16x8, pw0), __builtin_bit_cast(bf16x8, pw1), __builtin_bit_cast(bf16x8, pw2), __builtin_bit_cast(bf16x8, pw3));
            wdone = __all(R < R_STOP);
        }
        if (lane == 0) flg[(kt & 1) * 8 + wid] = wdone ? 1u : 0u;
        if (has_next) { *(LAS v4u*)(lds + (buf ^ 1) * L_BUF + L_K + sdst) = kreg; *(LAS v4u*)(lds + (buf ^ 1) * L_BUF + L_V + sdst) = vreg; }
        __syncthreads();
        unsigned alld = 1u;
#pragma unroll
        for (int w = 0; w < 8; ++w) alld &= flg[(kt & 1) * 8 + w];
        if (alld || !has_next) break;
        --kt; buf ^= 1;
    }
    LAS float* stg = (LAS float*)(lds + L_STG + wid * 8704);
#pragma unroll
    for (int r = 0; r < 16; ++r) { const int orow = crow(r, hi); stg[orow * 68 + r32] = o[0][r]; stg[orow * 68 + 32 + r32] = o[1][r]; }
    asm volatile("s_waitcnt lgkmcnt(0)" ::: "memory");
    bf16* Zw = P + (size_t)(q0 + 32 * wid) * PP + PC_SBZ + h * 64;
#pragma unroll
    for (int i = 0; i < 4; ++i) { const int row = i * 8 + (lane >> 3), ch = lane & 7;
        const f32x4 a = *(const LAS f32x4*)(stg + row * 68 + ch * 8), c = *(const LAS f32x4*)(stg + row * 68 + ch * 8 + 4);
        v4u* zp = (v4u*)(Zw + (size_t)row * PP + ch * 8); const v4u z = *zp; v4u y;
        y.x = pk2(a[0] * siluf(bflo(z.x)), a[1] * siluf(bfhi(z.x))); y.y = pk2(a[2] * siluf(bflo(z.y)), a[3] * siluf(bfhi(z.y)));
        y.z = pk2(c[0] * siluf(bflo(z.z)), c[1] * siluf(bfhi(z.z))); y.w = pk2(c[2] * siluf(bflo(z.w)), c[3] * siluf(bfhi(z.w)));
        *zp = y; }
}
}
namespace ssd {
typedef short bf16x8 __attribute__((ext_vector_type(8)));
typedef short s16x4 __attribute__((ext_vector_type(4)));
typedef float f32x16 __attribute__((ext_vector_type(16)));
typedef float f32x2_t __attribute__((ext_vector_type(2)));
typedef __bf16 bf16x2_t __attribute__((ext_vector_type(2)));
__device__ __forceinline__ unsigned cvtpk(float lo, float hi) { f32x2_t v = {lo, hi}; bf16x2_t b = __builtin_convertvector(v, bf16x2_t); return __builtin_bit_cast(unsigned, b); }
__device__ __forceinline__ int crow(int r, int hi) { return (r & 3) + 8 * (r >> 2) + 4 * hi; }
constexpr int PC_ = 272  , PT_ = 144  , PY_ = 272  ;
constexpr int O_CRM = 0, O_BRM = O_CRM + 64 * PC_, O_XST = O_BRM + 64 * PC_  , O_XT = O_XST + 64 * PT_  , O_HBF = O_XT + 64 * PT_,
              O_YB = O_HBF + 64 * PC_  , O_YD0 = O_YB + 64 * PY_  , O_YD1 = O_YD0 + 64 * PY_  , O_SC = O_YD1 + 32 * PY_  , O_CW = O_SC + 1024  , O_END = O_CW + 5 * 320 * 4;
static_assert(O_END <= 131072, "ssd lds");

__device__ __forceinline__ void conv8(const v4u (&raw)[4], const LAS float* cwp, float (&out)[8]) {
    const f32x4 b0 = *(const LAS f32x4*)(cwp + 4 * 320), b1 = *(const LAS f32x4*)(cwp + 4 * 320 + 4);
    float acc[8] = {b0[0], b0[1], b0[2], b0[3], b1[0], b1[1], b1[2], b1[3]};
#pragma unroll
    for (int k = 0; k < 4; ++k) { const f32x4 w0 = *(const LAS f32x4*)(cwp + k * 320), w1 = *(const LAS f32x4*)(cwp + k * 320 + 4); const v4u r = raw[k];
        acc[0] += w0[0] * bflo(r.x); acc[1] += w0[1] * bfhi(r.x); acc[2] += w0[2] * bflo(r.y); acc[3] += w0[3] * bfhi(r.y);
        acc[4] += w1[0] * bflo(r.z); acc[5] += w1[1] * bfhi(r.z); acc[6] += w1[2] * bflo(r.w); acc[7] += w1[3] * bfhi(r.w); }
#pragma unroll
    for (int i = 0; i < 8; ++i) out[i] = acc[i] * __builtin_amdgcn_rcpf(1.f + __builtin_amdgcn_exp2f(-1.4426950408889634f * acc[i]));
}


__device__ __forceinline__ void conv_fixup(Frame& F, const Args& args, int layer, int gtid, int gthreads) {
    const float* cw = argp(args, I_CONVW) + layer * 4 * 1536; const float* cb = argp(args, I_CONVB) + layer * 1536;
    bf16* PJ = WSP(F, WS_PROJ); const bf16* HL = WSP(F, WS_HALO);
    for (int j = gtid; j < (T / 64) * 192; j += gthreads) {
        const int blk = j / 192, ch0 = (j % 192) * 8;
        bf16* p = PJ + (size_t)blk * 64 * PP + PC_XBC + ch0;
        v4u r[6];
#pragma unroll
        for (int k = 0; k < 3; ++k) r[k] = (blk & 31) ? *(const v4u*)(HL + ((size_t)(blk - 1) * 3 + k) * 1536 + ch0) : (v4u){0u, 0u, 0u, 0u};
#pragma unroll
        for (int k = 0; k < 3; ++k) r[3 + k] = *(const v4u*)(p + (size_t)k * PP);
        float w[4][8], bsv[8];
#pragma unroll
        for (int k = 0; k < 4; ++k) { const f32x4 a = *(const f32x4*)(cw + k * 1536 + ch0), b = *(const f32x4*)(cw + k * 1536 + ch0 + 4); w[k][0] = a[0]; w[k][1] = a[1]; w[k][2] = a[2]; w[k][3] = a[3]; w[k][4] = b[0]; w[k][5] = b[1]; w[k][6] = b[2]; w[k][7] = b[3]; }
        { const f32x4 a = *(const f32x4*)(cb + ch0), b = *(const f32x4*)(cb + ch0 + 4); bsv[0] = a[0]; bsv[1] = a[1]; bsv[2] = a[2]; bsv[3] = a[3]; bsv[4] = b[0]; bsv[5] = b[1]; bsv[6] = b[2]; bsv[7] = b[3]; }
#pragma unroll
        for (int t = 0; t < 3; ++t) { float acc[8];
#pragma unroll
            for (int i = 0; i < 8; ++i) acc[i] = bsv[i];
#pragma unroll
            for (int k = 0; k < 4; ++k) { const v4u q = r[t + k];
                acc[0] += w[k][0] * bflo(q.x); acc[1] += w[k][1] * bfhi(q.x); acc[2] += w[k][2] * bflo(q.y); acc[3] += w[k][3] * bfhi(q.y);
                acc[4] += w[k][4] * bflo(q.z); acc[5] += w[k][5] * bfhi(q.z); acc[6] += w[k][6] * bflo(q.w); acc[7] += w[k][7] * bfhi(q.w); }
#pragma unroll
            for (int i = 0; i < 8; ++i) acc[i] = fsilu(acc[i]);
            *(v4u*)(p + (size_t)t * PP) = (v4u){cvtpk(acc[0], acc[1]), cvtpk(acc[2], acc[3]), cvtpk(acc[4], acc[5]), cvtpk(acc[6], acc[7])}; }
    }
}

__device__ __forceinline__ void ssd_item(Frame& F, const Args& args, int item, int layer) {
    int tid; { int t_ = threadIdx.x; asm volatile("" : "+v"(t_)); tid = t_; }
    const int lane = tid & 63, r32 = lane & 31, hi = lane >> 5; const int wid = __builtin_amdgcn_readfirstlane(tid >> 6);
    const int b = item >> 4, head = item & 15, g = head >> 3;
    bf16* P = WSP(F, WS_PROJ) + (size_t)b * SEQ * PP;
    float* ssqg = (float*)(F.ctl + CW_SSQG) + ((size_t)layer * T + (size_t)b * SEQ) * 2 + g;
    LAS unsigned char* lds = F.lds;
    LAS float* sc = (LAS float*)(lds + O_SC);
    LAS float* cwl = (LAS float*)(lds + O_CW);
    const float A = -expf(argp(args, I_ALOG)[layer * 16 + head]), Dk = argp(args, I_SSDD)[layer * 16 + head], dtb = argp(args, I_DTB)[layer * 16 + head];
    __syncthreads();
    {
      for (int e = tid; e < (64 * PC_) / 4; e += 512) ((LAS unsigned*)(lds + O_HBF))[e] = 0u; }
    const int xtok = tid >> 3, xcg = tid & 7;
    const bf16* xsrc = P + (size_t)xtok * PP + PC_XBC + head * 64 + xcg * 8;
    bf16* zsrc = P + (size_t)xtok * PP + PC_SSDZ + head * 64 + xcg * 8;
    const bf16* dsrc = P + (size_t)lane * PP + PC_DT + head;
    const int bctok0 = tid >> 5, bccg = tid & 31;
    const bf16* bcsrc = P + (size_t)bctok0 * PP + PC_XBC + 1024 + (bccg >> 4) * 256 + g * 128 + (bccg & 15) * 8;
    v4u xm, bcm[4], zr; unsigned short dtr;
#define SSD_LOAD(c) do { const size_t ro = (size_t)(c) * 64 * PP; xm = *(const v4u*)(xsrc + ro); \
        _Pragma("unroll") for (int j = 0; j < 4; ++j) bcm[j] = *(const v4u*)(bcsrc + ro + (size_t)(16 * j) * PP); \
        zr = *(const v4u*)(zsrc + ro); dtr = dsrc[ro]; } while (0)
    SSD_LOAD(0);
    f32x16 hacc = f32x16{};
    const int nt_ = wid >> 1, pt_ = wid & 1;
    __syncthreads();
    float xv[8]; v4u zcur; float dc = 1.f;
#define SSD_S0() do { float dtv, acs, wv; \
        { { const float x_ = bf2f(dtr) + dtb; dtv = fmaxf(x_, 0.f) + __logf(1.f + __expf(-fabsf(x_))); } float s_ = A * dtv; s_ = wave_scan(s_); acs = s_; const float tot = __shfl(s_, 63); wv = __expf(tot - acs) * dtv; dc = __expf(tot); \
          if (wid == 0) { sc[lane] = acs; sc[64 + lane] = dtv; sc[128 + lane] = __expf(acs); } } \
        { { xv[0] = bflo(xm.x); xv[1] = bfhi(xm.x); xv[2] = bflo(xm.y); xv[3] = bfhi(xm.y); xv[4] = bflo(xm.z); xv[5] = bfhi(xm.z); xv[6] = bflo(xm.w); xv[7] = bfhi(xm.w); } \
          const float wt = __shfl(wv, xtok); \
          *(LAS v4u*)(lds + O_XT + xtok * PT_ + xcg * 16) = xm; \
          *(LAS v4u*)(lds + O_XST + xtok * PT_ + xcg * 16) = (v4u){cvtpk(xv[0] * wt, xv[1] * wt), cvtpk(xv[2] * wt, xv[3] * wt), cvtpk(xv[4] * wt, xv[5] * wt), cvtpk(xv[6] * wt, xv[7] * wt)}; } \
        _Pragma("unroll") for (int j = 0; j < 4; ++j) *(LAS v4u*)(lds + (bccg < 16 ? O_BRM : O_CRM) + (bctok0 + 16 * j) * PC_ + (bccg & 15) * 16) = bcm[j]; \
        zcur = zr; } while (0)
    SSD_S0();
#pragma unroll 1
    for (int c = 0; c < 32; ++c) {
        __syncthreads();
        if (c + 1 < 32) SSD_LOAD(c + 1);
        if (wid < 3) {
            const int mt = wid >> 1, lt = (wid + 1) >> 1;
            f32x16 gacc = f32x16{};
            { bf16x8 fa[8], fb[8];
#pragma unroll
              for (int s = 0; s < 8; ++s) { fa[s] = *(const LAS bf16x8*)(lds + O_BRM + (32 * mt + r32) * PC_ + (16 * s + 8 * hi) * 2); fb[s] = *(const LAS bf16x8*)(lds + O_CRM + (32 * lt + r32) * PC_ + (16 * s + 8 * hi) * 2); }
#pragma unroll
              for (int s = 0; s < 8; ++s) gacc = __builtin_amdgcn_mfma_f32_32x32x16_bf16(fa[s], fb[s], gacc, 0, 0, 0); }
            const float acs_l = sc[32 * lt + r32]; const int lcol = 32 * lt + r32;
#pragma unroll
            for (int gq = 0; gq < 4; ++gq) { const int mb = 32 * mt + 8 * gq + 4 * hi; const f32x4 am = *(const LAS f32x4*)(sc + mb), dm = *(const LAS f32x4*)(sc + 64 + mb);
#pragma unroll
                for (int i = 0; i < 4; ++i) { const float t = gacc[4 * gq + i] * __expf(fminf(acs_l - am[i], 0.f)) * dm[i]; gacc[4 * gq + i] = (mb + i <= lcol) ? t : 0.f; } }
            const bf16x8 la0 = __builtin_bit_cast(bf16x8, (v4u){cvtpk(gacc[0], gacc[1]), cvtpk(gacc[2], gacc[3]), cvtpk(gacc[4], gacc[5]), cvtpk(gacc[6], gacc[7])});
            const bf16x8 la1 = __builtin_bit_cast(bf16x8, (v4u){cvtpk(gacc[8], gacc[9]), cvtpk(gacc[10], gacc[11]), cvtpk(gacc[12], gacc[13]), cvtpk(gacc[14], gacc[15])});
            LAS unsigned char* ydst = lds + (mt == 0 ? O_YD0 + 32 * lt * PY_ : O_YD1);
#pragma unroll
            for (int pt = 0; pt < 2; ++pt) { const bf16x8 x0 = tr_frag_perm(lds + O_XT, PT_, 32 * mt, 32 * pt, lane), x1 = tr_frag_perm(lds + O_XT, PT_, 32 * mt + 16, 32 * pt, lane);
                f32x16 yd = __builtin_amdgcn_mfma_f32_32x32x16_bf16(la0, x0, f32x16{}, 0, 0, 0);
                yd = __builtin_amdgcn_mfma_f32_32x32x16_bf16(la1, x1, yd, 0, 0, 0);
#pragma unroll
                for (int r = 0; r < 16; ++r) *((LAS float*)(ydst + crow(r, hi) * PY_) + 32 * pt + r32) = yd[r]; }
        } else if (wid < 7) {
            const int lt = (wid - 3) >> 1, pt = (wid - 3) & 1;
            f32x16 yo = f32x16{};
            { bf16x8 fa[8], fb[8];
#pragma unroll
              for (int s = 0; s < 8; ++s) { fa[s] = *(const LAS bf16x8*)(lds + O_CRM + (32 * lt + r32) * PC_ + (16 * s + 8 * hi) * 2); fb[s] = *(const LAS bf16x8*)(lds + O_HBF + (32 * pt + r32) * PC_ + (16 * s + 8 * hi) * 2); }
#pragma unroll
              for (int s = 0; s < 8; ++s) yo = __builtin_amdgcn_mfma_f32_32x32x16_bf16(fa[s], fb[s], yo, 0, 0, 0); }
#pragma unroll
            for (int gq = 0; gq < 4; ++gq) { const int lb = 32 * lt + 8 * gq + 4 * hi; const f32x4 el = *(const LAS f32x4*)(sc + 128 + lb);
#pragma unroll
                for (int i = 0; i < 4; ++i) *((LAS float*)(lds + O_YB + (lb + i) * PY_) + 32 * pt + r32) = yo[4 * gq + i] * el[i]; }
        }
        hacc = hacc * dc;
        { bf16x8 fa[4], fb[4];
#pragma unroll
          for (int s = 0; s < 4; ++s) { fa[s] = tr_frag(lds + O_BRM, PC_, 16 * s + 8 * hi, 32 * nt_, lane); fb[s] = tr_frag(lds + O_XST, PT_, 16 * s + 8 * hi, 32 * pt_, lane); }
#pragma unroll
          for (int s = 0; s < 4; ++s) hacc = __builtin_amdgcn_mfma_f32_32x32x16_bf16(fa[s], fb[s], hacc, 0, 0, 0); }
        __syncthreads();
        { const LAS float* yb = (const LAS float*)(lds + O_YB + xtok * PY_) + xcg * 8; const LAS float* y0p = (const LAS float*)(lds + O_YD0 + xtok * PY_) + xcg * 8;
          f32x4 y0 = *(const LAS f32x4*)yb + *(const LAS f32x4*)y0p, y1 = *(const LAS f32x4*)(yb + 4) + *(const LAS f32x4*)(y0p + 4);
          if (xtok >= 32) { const LAS float* y1p = (const LAS float*)(lds + O_YD1 + (xtok - 32) * PY_) + xcg * 8; y0 = y0 + *(const LAS f32x4*)y1p; y1 = y1 + *(const LAS f32x4*)(y1p + 4); }
          float yg[8];
          yg[0] = (y0[0] + Dk * xv[0]) * fsilu(bflo(zcur.x)); yg[1] = (y0[1] + Dk * xv[1]) * fsilu(bfhi(zcur.x)); yg[2] = (y0[2] + Dk * xv[2]) * fsilu(bflo(zcur.y)); yg[3] = (y0[3] + Dk * xv[3]) * fsilu(bfhi(zcur.y));
          yg[4] = (y1[0] + Dk * xv[4]) * fsilu(bflo(zcur.z)); yg[5] = (y1[1] + Dk * xv[5]) * fsilu(bfhi(zcur.z)); yg[6] = (y1[2] + Dk * xv[6]) * fsilu(bflo(zcur.w)); yg[7] = (y1[3] + Dk * xv[7]) * fsilu(bfhi(zcur.w));
          float s = 0.f;
#pragma unroll
          for (int i = 0; i < 8; ++i) s += yg[i] * yg[i];
          s += __shfl_xor(s, 1); s += __shfl_xor(s, 2); s += __shfl_xor(s, 4);
          if (xcg == 0) atomicAdd(ssqg + (size_t)(c * 64 + xtok) * 2, s);
          v4u o; o.x = cvtpk(yg[0], yg[1]); o.y = cvtpk(yg[2], yg[3]); o.z = cvtpk(yg[4], yg[5]); o.w = cvtpk(yg[6], yg[7]);
          *(v4u*)(zsrc + (size_t)c * 64 * PP) = o; }
#pragma unroll
        for (int gq = 0; gq < 4; ++gq) { v2u w; w.x = cvtpk(hacc[4 * gq], hacc[4 * gq + 1]); w.y = cvtpk(hacc[4 * gq + 2], hacc[4 * gq + 3]);
            *(LAS v2u*)(lds + O_HBF + (32 * pt_ + r32) * PC_ + (32 * nt_ + 8 * gq + 4 * hi) * 2) = w; }
        if (c + 1 < 32) SSD_S0();
    }
#undef SSD_S0
#undef SSD_LOAD
}
}
namespace gla {
typedef short bf16x8 __attribute__((ext_vector_type(8)));
typedef float f32x16 __attribute__((ext_vector_type(16)));
typedef float f32x2_t __attribute__((ext_vector_type(2)));
typedef __bf16 bf16x2_t __attribute__((ext_vector_type(2)));
__device__ __forceinline__ unsigned cvtpk(float lo, float hi) { f32x2_t v = {lo, hi}; bf16x2_t b = __builtin_convertvector(v, bf16x2_t); return __builtin_bit_cast(unsigned, b); }
__device__ __forceinline__ int crow(int r, int hi) { return (r & 3) + 8 * (r >> 2) + 4 * hi; }
constexpr int PT_ = 144;
constexpr int PO_ = 528;
constexpr int PV_ = 272;
constexpr int O_QT = 0, O_KRM = O_QT + 64 * PT_, O_VT = O_KRM + 64 * PT_  , O_ST = O_VT + 64 * PV_, O_OB = O_ST + 128 * PT_, O_AT = O_OB + 64 * PO_  ,
              O_EG = O_AT + 64 * PT_  , O_GW = O_EG + 256  , O_GB = O_GW + 4096  , O_NW = O_GB + 256  , O_END = O_NW + 512;
static_assert(O_END <= 131072, "gla lds");


__device__ __forceinline__ void gla_prepass(Frame& F, const Args& args, int grp, int layer) {
    int tid; { int t_ = threadIdx.x; asm volatile("" : "+v"(t_)); tid = t_; }
    const int lane = tid & 63; const int wid = __builtin_amdgcn_readfirstlane(tid >> 6);
    const int b = grp >> 5, h = (grp >> 3) & 3, c0 = (grp & 7) * 4, kd0 = 8 * wid;
    bf16* P = WSP(F, WS_PROJ) + (size_t)b * SEQ * PP;
    float* EG = (float*)(F.ws + WS_EG) + ((size_t)(b * 4 + h) * 32) * 64;
    LAS unsigned char* lds = F.lds;
    LAS float* gwl = (LAS float*)(lds + O_GW); LAS float* gbl = (LAS float*)(lds + O_GB);
    __syncthreads();
    { const float* gw = argp(args, I_GATEW) + layer * 16 * 256; const float* gb = argp(args, I_GATEB) + layer * 256;
      for (int e = tid; e < 1024; e += 512) gwl[e] = gw[(e >> 6) * 256 + h * 64 + (e & 63)];
      if (tid < 64) gbl[tid] = gb[h * 64 + tid]; }
    bf16* qp = P + (size_t)(c0 * 64 + lane) * PP + PC_GQ + h * 64 + kd0;
    bf16* kp = P + (size_t)(c0 * 64 + lane) * PP + PC_GK + h * 64 + kd0;
    const bf16* gp = P + (size_t)(c0 * 64 + lane) * PP + PC_GLR;
    v4u qr[4], kr[4], g0[4], g1[4];
#pragma unroll
    for (int j = 0; j < 4; ++j) { const size_t ro = (size_t)j * 64 * PP; qr[j] = *(const v4u*)(qp + ro); kr[j] = *(const v4u*)(kp + ro); g0[j] = *(const v4u*)(gp + ro); g1[j] = *(const v4u*)(gp + ro + 8); }
    __syncthreads();
#pragma unroll
    for (int j = 0; j < 4; ++j) {
        const unsigned gwv[8] = {g0[j].x, g0[j].y, g0[j].z, g0[j].w, g1[j].x, g1[j].y, g1[j].z, g1[j].w};
        float G[8];
        { const f32x4 b0 = *(const LAS f32x4*)(gbl + kd0), b1 = *(const LAS f32x4*)(gbl + kd0 + 4); G[0] = b0[0]; G[1] = b0[1]; G[2] = b0[2]; G[3] = b0[3]; G[4] = b1[0]; G[5] = b1[1]; G[6] = b1[2]; G[7] = b1[3]; }
#pragma unroll
        for (int r = 0; r < 16; ++r) { const float gl = (r & 1) ? bfhi(gwv[r >> 1]) : bflo(gwv[r >> 1]); const f32x4 w0 = *(const LAS f32x4*)(gwl + r * 64 + kd0), w1 = *(const LAS f32x4*)(gwl + r * 64 + kd0 + 4);
            G[0] += gl * w0[0]; G[1] += gl * w0[1]; G[2] += gl * w0[2]; G[3] += gl * w0[3]; G[4] += gl * w1[0]; G[5] += gl * w1[1]; G[6] += gl * w1[2]; G[7] += gl * w1[3]; }
#pragma unroll
        for (int i = 0; i < 8; ++i) { const float x = G[i]; const float s = (fminf(x, 0.f) - __logf(1.f + __expf(-fabsf(x)))) * (1.f / 16.f); G[i] = wave_scan(s); }
        const float qf[8] = {bflo(qr[j].x), bfhi(qr[j].x), bflo(qr[j].y), bfhi(qr[j].y), bflo(qr[j].z), bfhi(qr[j].z), bflo(qr[j].w), bfhi(qr[j].w)};
        const float kf[8] = {bflo(kr[j].x), bfhi(kr[j].x), bflo(kr[j].y), bfhi(kr[j].y), bflo(kr[j].z), bfhi(kr[j].z), bflo(kr[j].w), bfhi(kr[j].w)};
        float qt[8], kt[8];
#pragma unroll
        for (int i = 0; i < 8; ++i) { const float eg = __expf(G[i]); qt[i] = qf[i] * eg; kt[i] = kf[i] * __expf(fminf(-G[i], 80.f)); if (lane == 63) EG[(c0 + j) * 64 + kd0 + i] = eg; }
        const size_t ro = (size_t)j * 64 * PP;
        *(v4u*)(qp + ro) = (v4u){cvtpk(qt[0], qt[1]), cvtpk(qt[2], qt[3]), cvtpk(qt[4], qt[5]), cvtpk(qt[6], qt[7])};
        *(v4u*)(kp + ro) = (v4u){cvtpk(kt[0], kt[1]), cvtpk(kt[2], kt[3]), cvtpk(kt[4], kt[5]), cvtpk(kt[6], kt[7])};
    }
}

__device__ __forceinline__ void gla_item(Frame& F, const Args& args, int item, int layer) {
    int tid; { int t_ = threadIdx.x; asm volatile("" : "+v"(t_)); tid = t_; }
    const int lane = tid & 63, r32 = lane & 31, hi = lane >> 5; const int wid = __builtin_amdgcn_readfirstlane(tid >> 6);
    const int b = item >> 2, h = item & 3;
    bf16* P = WSP(F, WS_PROJ) + (size_t)b * SEQ * PP;
    LAS unsigned char* lds = F.lds;
    LAS float* egl = (LAS float*)(lds + O_EG); LAS float* gwl = (LAS float*)(lds + O_GW); LAS float* gbl = (LAS float*)(lds + O_GB); LAS float* nwl = (LAS float*)(lds + O_NW);
    __syncthreads();
    { const float* nw = argp(args, I_GLANW) + layer * 128;
      if (tid < 128) nwl[tid] = nw[tid];
      for (int e = tid; e < (128 * PT_ + 64 * PO_ + 64 * PT_) / 4; e += 512) ((LAS unsigned*)(lds + O_ST))[e] = 0u; }
    const int jtok = tid >> 3, jg = tid & 7;
    const bf16* qsrc = P + (size_t)jtok * PP + PC_GQ + h * 64 + jg * 8;
    const bf16* ksrc = P + (size_t)jtok * PP + PC_GK + h * 64 + jg * 8;
    const float* egsrc = (const float*)(F.ws + WS_EG) + ((size_t)(b * 4 + h) * 32) * 64 + (tid & 63);
    const int vtok0 = tid >> 4, vg = tid & 15;
    const bf16* vsrc = P + (size_t)vtok0 * PP + PC_GV + h * 128 + vg * 8;
    const int otok = tid >> 3, og = tid & 7;
    bf16* zsrc = P + (size_t)otok * PP + PC_GZ + h * 128 + og * 16;
    v4u qr, kr, vr[2], zr0, zr1; float egr;
#define GLA_LOAD(c) do { const size_t ro = (size_t)(c) * 64 * PP; qr = *(const v4u*)(qsrc + ro); kr = *(const v4u*)(ksrc + ro); egr = egsrc[(c) * 64]; \
        vr[0] = *(const v4u*)(vsrc + ro); vr[1] = *(const v4u*)(vsrc + ro + (size_t)32 * PP); zr0 = *(const v4u*)(zsrc + ro); zr1 = *(const v4u*)(zsrc + ro + 8); } while (0)
    GLA_LOAD(0);
    f32x16 sacc = f32x16{};
    const int kt_ = wid >> 2, vt_ = wid & 3;
    __syncthreads();
    unsigned pacc0 = 0, pacc1 = 0, pacc2 = 0;
#pragma unroll 1
    for (int c = 0; c < 32; ++c) {
        const unsigned pt0 = MK_PROBE ? (unsigned)__builtin_amdgcn_s_memrealtime() : 0u;
        *(LAS v4u*)(lds + O_QT + jtok * PT_ + jg * 16) = qr; *(LAS v4u*)(lds + O_KRM + jtok * PT_ + jg * 16) = kr;
        if (tid < 64) egl[tid] = egr;
#pragma unroll
        for (int j = 0; j < 2; ++j) *(LAS v4u*)(lds + O_VT + (vtok0 + 32 * j) * PV_ + vg * 16) = vr[j];
        const v4u zc0 = zr0, zc1 = zr1;
        __syncthreads();
        const unsigned pt1 = MK_PROBE ? (unsigned)__builtin_amdgcn_s_memrealtime() : 0u;
        if (c + 1 < 32) GLA_LOAD(c + 1);
        if (wid < 3) {
            const int st = wid >> 1, tt = (wid + 1) >> 1;
            f32x16 at = f32x16{};
            { bf16x8 fa[4], fb[4];
#pragma unroll
              for (int s = 0; s < 4; ++s) { fa[s] = *(const LAS bf16x8*)(lds + O_KRM + (32 * st + r32) * PT_ + (16 * s + 8 * hi) * 2); fb[s] = *(const LAS bf16x8*)(lds + O_QT + (32 * tt + r32) * PT_ + (16 * s + 8 * hi) * 2); }
#pragma unroll
              for (int s = 0; s < 4; ++s) at = __builtin_amdgcn_mfma_f32_32x32x16_bf16(fa[s], fb[s], at, 0, 0, 0); }
            if (st == tt) {
#pragma unroll
                for (int r = 0; r < 16; ++r) if (crow(r, hi) > r32) at[r] = 0.f; }
#pragma unroll
            for (int gq = 0; gq < 4; ++gq) *(LAS v2u*)(lds + O_AT + (32 * tt + r32) * PT_ + (32 * st + 8 * gq + 4 * hi) * 2) = (v2u){cvtpk(at[4 * gq], at[4 * gq + 1]), cvtpk(at[4 * gq + 2], at[4 * gq + 3])};
        }
        {
            { bf16x8 fa[4], fb[4];
#pragma unroll
              for (int s = 0; s < 4; ++s) { fa[s] = tr_frag(lds + O_KRM, PT_, 16 * s + 8 * hi, 32 * kt_, lane); fb[s] = tr_frag(lds + O_VT, PV_, 16 * s + 8 * hi, 32 * vt_, lane); }
#pragma unroll
              for (int s = 0; s < 4; ++s) sacc = __builtin_amdgcn_mfma_f32_32x32x16_bf16(fa[s], fb[s], sacc, 0, 0, 0); }
#pragma unroll
            for (int gq = 0; gq < 4; ++gq) { const f32x4 e = *(const LAS f32x4*)(egl + 32 * kt_ + 8 * gq + 4 * hi);
                sacc[4 * gq] *= e[0]; sacc[4 * gq + 1] *= e[1]; sacc[4 * gq + 2] *= e[2]; sacc[4 * gq + 3] *= e[3]; }
        }
        __syncthreads();
        {
            f32x16 oi = f32x16{};
            { bf16x8 fa[4], fb[4];
#pragma unroll
              for (int s = 0; s < 4; ++s) { fa[s] = *(const LAS bf16x8*)(lds + O_QT + (32 * kt_ + r32) * PT_ + (16 * s + 8 * hi) * 2); fb[s] = *(const LAS bf16x8*)(lds + O_ST + (32 * vt_ + r32) * PT_ + (16 * s + 8 * hi) * 2); }
#pragma unroll
              for (int s = 0; s < 4; ++s) oi = __builtin_amdgcn_mfma_f32_32x32x16_bf16(fa[s], fb[s], oi, 0, 0, 0); }
#pragma unroll
            for (int s = 0; s < 4; ++s) if (s < 2 || kt_) { const bf16x8 a = *(const LAS bf16x8*)(lds + O_AT + (32 * kt_ + r32) * PT_ + (16 * s + 8 * hi) * 2), bb = tr_frag(lds + O_VT, PV_, 16 * s + 8 * hi, 32 * vt_, lane);
                oi = __builtin_amdgcn_mfma_f32_32x32x16_bf16(a, bb, oi, 0, 0, 0); }
#pragma unroll
            for (int r = 0; r < 16; ++r) *((LAS float*)(lds + O_OB + (32 * kt_ + crow(r, hi)) * PO_) + 32 * vt_ + r32) = oi[r];
        }
        __syncthreads();
        const unsigned pt2 = MK_PROBE ? (unsigned)__builtin_amdgcn_s_memrealtime() : 0u;
        { LAS float* ob = (LAS float*)(lds + O_OB + otok * PO_) + og * 16; float o[16];
#pragma unroll
          for (int q4 = 0; q4 < 4; ++q4) { const f32x4 t4 = *(const LAS f32x4*)(ob + 4 * q4); o[4 * q4] = t4[0]; o[4 * q4 + 1] = t4[1]; o[4 * q4 + 2] = t4[2]; o[4 * q4 + 3] = t4[3]; }
          float s = 0.f;
#pragma unroll
          for (int i = 0; i < 16; ++i) s += o[i] * o[i];
          s += __shfl_xor(s, 1); s += __shfl_xor(s, 2); s += __shfl_xor(s, 4);
          const float rs = rsqrtf(s * (1.f / 128.f) + EPS);
          const unsigned zw[8] = {zc0.x, zc0.y, zc0.z, zc0.w, zc1.x, zc1.y, zc1.z, zc1.w};
          unsigned ow[8];
          float nwv[16];
#pragma unroll
          for (int q4 = 0; q4 < 4; ++q4) { const f32x4 t4 = *(const LAS f32x4*)(nwl + og * 16 + 4 * q4); nwv[4 * q4] = t4[0]; nwv[4 * q4 + 1] = t4[1]; nwv[4 * q4 + 2] = t4[2]; nwv[4 * q4 + 3] = t4[3]; }
#pragma unroll
          for (int i = 0; i < 8; ++i) { const float y0 = o[2 * i] * rs * nwv[2 * i] * fsilu(bflo(zw[i])), y1 = o[2 * i + 1] * rs * nwv[2 * i + 1] * fsilu(bfhi(zw[i])); ow[i] = cvtpk(y0, y1); }
          bf16* dst = zsrc + (size_t)c * 64 * PP;
          *(v4u*)dst = (v4u){ow[0], ow[1], ow[2], ow[3]}; *(v4u*)(dst + 8) = (v4u){ow[4], ow[5], ow[6], ow[7]}; }
#pragma unroll
        for (int gq = 0; gq < 4; ++gq) { v2u w; w.x = cvtpk(sacc[4 * gq], sacc[4 * gq + 1]); w.y = cvtpk(sacc[4 * gq + 2], sacc[4 * gq + 3]);
            *(LAS v2u*)(lds + O_ST + (32 * vt_ + r32) * PT_ + (32 * kt_ + 8 * gq + 4 * hi) * 2) = w; }
        __syncthreads();
        if (MK_PROBE) { const unsigned pt3 = (unsigned)__builtin_amdgcn_s_memrealtime(); pacc0 += pt1 - pt0; pacc1 += pt2 - pt1; pacc2 += pt3 - pt2; }
    }
    if (MK_PROBE && item == 0 && layer == 0 && tid == 0) { unsigned* ts = (unsigned*)(F.ctl + CW_TS); ts[40] = pacc0; ts[41] = pacc1; ts[42] = pacc2; ts[43] = 0u; }
#undef GLA_LOAD
}
}
#ifndef MK_N_LAUNCHES
#define MK_N_LAUNCHES 1
#endif
constexpr int N_PHASES = 8;

__device__ __forceinline__ void p0_prologue(Frame& F, const Args& args) {
    LAS float* scr = (LAS float*)(F.lds + RING_OFF + F.wave * 16384);
    const int gw = F.vcu * NWAVES + F.wave, NGW = F.G * NWAVES;
    constexpr int NITEMS = CVT_WIN_ITEMS + CVT_WOUT_ITEMS;
    for (int it = gw; it < NITEMS; it += NGW) {
        if (it < CVT_WIN_ITEMS) cvt_win_item(argp(args, I_WIN), argp(args, I_NORMW), WSP(F, WS_WIN), scr, it, F.lane);
        else cvt_wout_item(argp(args, I_WOUT), argp(args, I_SSDNW), WSP(F, WS_WOUT), scr, it - CVT_WIN_ITEMS, F.lane);
    }
    float* ssq0 = (float*)(F.ctl + CW_SSQX);
    for (int m = gw; m < T; m += NGW) row_to_bf16(argp(args, I_X) + (size_t)m * DM, WSP(F, WS_XB) + (size_t)m * DM, ssq0 + m, F.lane);
}

#define STAMP_MAX(k) do { if (MK_PROBE && F.tid == 0) atomicMax((unsigned*)(F.ctl + CW_TS + 32 + (k)), (unsigned)__builtin_amdgcn_s_memrealtime()); } while (0)
#define QUEUE_LOOP(qword, nitems, body) for (;;) { __syncthreads(); if (F.tid == 0) F.MISC[16] = __hip_atomic_fetch_add((unsigned*)(F.ctl + (qword)), 1u, RLX_AGENT); __syncthreads(); \
        const int item = (int)F.MISC[16]; if (item >= (nitems)) break; body; }
__device__ __forceinline__ void p_mixers(Frame& F, const Args& args, int layer) {
    constexpr int N_SSD = 128, N_GLA = 32, N_SB = 512;
    const int q0 = CW_Q + 256 * layer;
    QUEUE_LOOP(q0, N_GLA, gla::gla_item(F, args, item, layer)); if (layer == 0) STAMP_MAX(0);
    QUEUE_LOOP(q0 + 64, N_SSD, ssd::ssd_item(F, args, item, layer)); if (layer == 0) STAMP_MAX(1);
    QUEUE_LOOP(q0 + 128, N_SB, sba::sb_item(F, item)); if (layer == 0) STAMP_MAX(2);
    LAS float* scr = (LAS float*)(F.lds + RING_OFF + F.wave * 16384);
    if (layer == 0) { QUEUE_LOOP(q0 + 192, CVT_WIN_ITEMS / 8, cvt_win_item(argp(args, I_WIN) + (size_t)DM * NPROJ, argp(args, I_NORMW) + DM, WSP(F, WS_WIN), scr, item * 8 + F.wave, F.lane)); STAMP_MAX(3); }
    else { QUEUE_LOOP(q0 + 192, CVT_WOUT_ITEMS / 8, cvt_wout_item(argp(args, I_WOUT) + (size_t)DI * DM, argp(args, I_SSDNW) + 1024, WSP(F, WS_WOUT), scr, item * 8 + F.wave, F.lane)); }
}


__device__ __forceinline__ void small_unit(Frame& F, int u, const float* ssq) {
    typedef float f32x16 __attribute__((ext_vector_type(16)));
    int tid; { int t_ = threadIdx.x; asm volatile("" : "+v"(t_)); tid = t_; }
    const int lane = tid & 63, r32 = lane & 31, hi = lane >> 5; const int wid = __builtin_amdgcn_readfirstlane(tid >> 6);
    const int rh = wid & 1, kq = wid >> 1;
    const bf16* A = WSP(F, WS_XB) + (size_t)(u * 64 + rh * 32 + r32) * DM + kq * 256 + hi * 8;
    const bf16* B = WSP(F, WS_WIN) + (size_t)(NMAIN + r32) * DM + kq * 256 + hi * 8;
    f32x16 acc = f32x16{};
    bf16x8_t af[16], bfr[16];
#pragma unroll
    for (int s = 0; s < 16; ++s) { af[s] = *(const bf16x8_t*)(A + 16 * s); bfr[s] = *(const bf16x8_t*)(B + 16 * s); }
#pragma unroll
    for (int s = 0; s < 16; ++s) acc = __builtin_amdgcn_mfma_f32_32x32x16_bf16(af[s], bfr[s], acc, 0, 0, 0);
    LAS float* red = (LAS float*)(F.lds);
    __syncthreads();
#pragma unroll
    for (int r = 0; r < 16; ++r) red[(kq * 64 + rh * 32 + (r & 3) + 8 * (r >> 2) + 4 * hi) * 33 + r32] = acc[r];
    __syncthreads();
    { const int row = tid >> 3, c4 = (tid & 7) * 4; float v[4];
#pragma unroll
      for (int i = 0; i < 4; ++i) v[i] = red[(0 * 64 + row) * 33 + c4 + i] + red[(1 * 64 + row) * 33 + c4 + i] + red[(2 * 64 + row) * 33 + c4 + i] + red[(3 * 64 + row) * 33 + c4 + i];
      const int grow = u * 64 + row; const float rs = rsqrtf(ssq[grow] * (1.0f / 1024.0f) + EPS);
      v2u w; w.x = pk2(v[0] * rs, v[1] * rs); w.y = pk2(v[2] * rs, v[3] * rs);
      *(v2u*)(WSP(F, WS_PROJ) + (size_t)grow * PP + NMAIN + c4) = w; }
}

__global__ void __launch_bounds__(NWAVES * 64, 2) mk_fwd(Args args) {
    extern __shared__ __attribute__((aligned(16))) unsigned char lds[];
    Frame F;
    F.lds = (LAS unsigned char*)lds;
    F.MISC = (volatile LAS unsigned*)(F.lds + MISC_OFF);
    F.tid = threadIdx.x; F.lane = F.tid & 63; F.wave = __builtin_amdgcn_readfirstlane(F.tid >> 6);
    F.G = gridDim.x; { const int bx = blockIdx.x; F.vcu = (F.G % 8 == 0) ? (bx % 8) * (F.G / 8) + bx / 8 : bx; }
    F.ws = args.ws;
    F.ctl = (gu32*)(F.ws + WS_CTL);
    for (int u = F.tid; u < (LDS_BYTES - LDSCTL_OFF) / 4; u += NWAVES * 64) ((LAS unsigned*)(F.lds + LDSCTL_OFF))[u] = 0u;
    __syncthreads();
    XcdBarrier bar; bar.bar = (unsigned*)(F.ctl + CW_BAR); bar.x = 0; bar.st = nullptr;
    if (MK_N_LAUNCHES == 1) bar = xcd_barrier_post((unsigned*)(F.ctl + CW_BAR), F.MISC + 8);
#define GRID_BAR() do { if (MK_N_LAUNCHES == 1) xcd_barrier<false>(bar); } while (0)
    const int lo = args.ph_lo, hi = args.ph_hi;
    int n_stamp = 0;
#define STAMP() do { if (MK_PROBE && blockIdx.x == 0 && F.tid == 0) __hip_atomic_store((unsigned*)(F.ctl + CW_TS + n_stamp), (unsigned)__builtin_amdgcn_s_memrealtime(), RLX_AGENT); ++n_stamp; } while (0)
    STAMP();
#define IN(k) (lo <= (k) && (k) < hi)
    if (IN(0)) { p0_prologue(F, args); if (MK_N_LAUNCHES == 1) xcd_barrier<true>(bar); } STAMP();
#pragma unroll 1
    for (int layer = 0; layer < DEPTH; ++layer) {
        float* ssq_in = (float*)(F.ctl + CW_SSQX) + layer * T;
        float* ssq_next = ssq_in + T;
        if (IN(1 + 3 * layer)) {
            pg8::Gemm g{WSP(F, WS_XB), WSP(F, WS_WIN), T, NMAIN, DM, DM}; pg8::StaticOrder S; S.init(T, NMAIN, F.G, (int)blockIdx.x);
            pg8::EpiProj E{WSP(F, WS_PROJ), PP, ssq_in, argp(args, I_CONVW) + layer * 4 * 1536, argp(args, I_CONVB) + layer * 1536, WSP(F, WS_HALO)};
            pg8::gemm_phase<pg8::EpiProj, true, false, DM, DM>(F.lds + RING_OFF, g, S, E, nullptr);
            for (int u = blockIdx.x; u < T / 64; u += F.G) small_unit(F, u, ssq_in);
            GRID_BAR();
        } STAMP();
        if (IN(2 + 3 * layer)) { for (int grp = blockIdx.x; grp < 256; grp += F.G) gla::gla_prepass(F, args, grp, layer); ssd::conv_fixup(F, args, layer, (int)(blockIdx.x * (NWAVES * 64) + threadIdx.x), (int)(F.G * NWAVES * 64)); GRID_BAR(); p_mixers(F, args, layer); GRID_BAR(); } STAMP();
        if (IN(3 + 3 * layer)) {
            pg8::Gemm g{WSP(F, WS_PROJ) + PC_Y, WSP(F, WS_WOUT), T, DM, DI, PP}; pg8::StaticOrder S; S.init(T, DM, F.G, (int)blockIdx.x);
            LAS float* hsc = (LAS float*)(F.lds + HSC_OFF);
            { pg8::Unit u; if (S.next(0, u) && F.tid < 256) { const float* sg = (const float*)(F.ctl + CW_SSQG) + ((size_t)layer * T + (size_t)u.pm * 256 + F.tid) * 2;
                  const float r0 = rsqrtf(sg[0] * (1.f / 512.f) + EPS), r1 = rsqrtf(sg[1] * (1.f / 512.f) + EPS); hsc[F.tid * 2 + 0] = r0 / r1; hsc[F.tid * 2 + 1] = r1; } }
            VM_WAIT(); __syncthreads();
            pg8::EpiOut E{layer == 0 ? argp(args, I_X) : args.out, args.out, WSP(F, WS_XB), ssq_next, layer == 0 ? 1 : 0};
            pg8::gemm_phase<pg8::EpiOut, false, true, DI, PP>(F.lds + RING_OFF, g, S, E, hsc);
            GRID_BAR();
        } STAMP();
    }
    if (IN(7)) {
        const float* ssq2 = (const float*)(F.ctl + CW_SSQX) + 2 * T;
        const int gw = F.vcu * NWAVES + F.wave, NGW = F.G * NWAVES;
        float pscale = 1.f;
#if MK_PROBE
        { const unsigned* ts = (const unsigned*)(F.ctl + CW_TS); const int a = MK_PROBE_A, b = MK_PROBE_B;
          const float us = (float)(__hip_atomic_load(ts + a, RLX_AGENT) - __hip_atomic_load(ts + b, RLX_AGENT)) * 0.01f; pscale = 1.f + sqrtf(us * 1e-5f); }
#endif
        for (int m = gw; m < T; m += NGW) {
            const float rs = pscale * rsqrtf(ssq2[m] * (1.f / 1024.f) + EPS);
            GAS f32x4* xr = (GAS f32x4*)(args.out + (size_t)m * DM) + F.lane; const GAS f32x4* wr_ = (const GAS f32x4*)argp(args, I_FINW) + F.lane;
#pragma unroll
            for (int j = 0; j < 4; ++j) { f32x4 v = xr[64 * j]; const f32x4 w = wr_[64 * j]; v = v * rs * w; xr[64 * j] = v; }
        }
    }
#undef IN
#undef GRID_BAR
}

extern "C" void kernel_launch(void* const* d_in, const int* in_sizes, int n_in, void* d_out, int out_size, void* d_ws, size_t ws_size, hipStream_t stream) {
    static int grid = 0;
    if (grid == 0) {
        if (n_in != 14 || in_sizes[0] != T * DM || out_size != T * DM || ws_size < WS_END) { fprintf(stderr, "kernel_launch: unexpected shapes (n_in %d in0 %d out %d ws %zu)\n", n_in, n_in > 0 ? in_sizes[0] : -1, out_size, ws_size); grid = -1; return; }
        int dev = 0, cus = 0, per_cu = 0;
        if (hipGetDevice(&dev) != hipSuccess || hipDeviceGetAttribute(&cus, hipDeviceAttributeMultiprocessorCount, dev) != hipSuccess) { grid = -1; return; }
        if (hipFuncSetAttribute((const void*)mk_fwd, hipFuncAttributeMaxDynamicSharedMemorySize, LDS_BYTES) != hipSuccess) { fprintf(stderr, "kernel_launch: hipFuncSetAttribute failed\n"); grid = -1; return; }
        if (hipOccupancyMaxActiveBlocksPerMultiprocessor(&per_cu, (const void*)mk_fwd, NWAVES * 64, LDS_BYTES) != hipSuccess || per_cu < 1) { fprintf(stderr, "kernel_launch: occupancy query says %d blocks/CU\n", per_cu); }
        (void)hipGetLastError();
        grid = cus;
        if (grid != 256) fprintf(stderr, "kernel_launch: %d CUs (expected 256)\n", grid);
    }
    if (grid < 0) return;
    (void)hipMemsetAsync((char*)d_ws + WS_CTL, 0, CTL_ZERO_BYTES, stream);
    Args a{};
    for (int i = 0; i < 14; ++i) a.in[i] = (const float*)d_in[i];
    a.out = (float*)d_out; a.ws = (unsigned char*)d_ws;
    if (MK_N_LAUNCHES == 1) { a.ph_lo = 0; a.ph_hi = N_PHASES; hipLaunchKernelGGL(mk_fwd, dim3(grid), dim3(NWAVES * 64), LDS_BYTES, stream, a); }
    else for (int p = 0; p < N_PHASES; ++p) { a.ph_lo = p; a.ph_hi = p + 1; hipLaunchKernelGGL(mk_fwd, dim3(grid), dim3(NWAVES * 64), LDS_BYTES, stream, a); }
}
```
